# Optimizing an MI355X kernel written in HIP

```python
import math
import jax, jax.numpy as jnp
from jax import lax
import numpy as np

D_MODEL = 2048
BATCH = 2
SEQ = 8192
DEPTH = 1
DEC_BATCH = 32
DEC_SEQ = 16
PAST_LEN = 1024

CHUNK = 64
Q_BLOCK = 128
HEAD_DIM = 128
N_DIFF_HEADS = D_MODEL // (2 * HEAD_DIM)
N_FOX_HEADS = D_MODEL // (2 * HEAD_DIM)
DIFF_QK_DIM = HEAD_DIM // 2
DIFF_W = N_DIFF_HEADS * HEAD_DIM
FOX_W = N_FOX_HEADS * HEAD_DIM
D_FF = 4 * D_MODEL
CONV_WIDTH = 3
REL_BUCKETS = 32
REL_MAX_DIST = 128
N_IN = 3 * DIFF_W + 3 * FOX_W + N_FOX_HEADS + 2 * D_MODEL
EPS = 1e-6
NEG_INF = -1e30

kernel_name = "streaming_diff_fox_hybrid_step"


def _rms(x, g):
    xf = x.astype(jnp.float32)
    y = xf * lax.rsqrt(jnp.mean(xf * xf, axis=-1, keepdims=True) + EPS)
    return (y * g.astype(jnp.float32)).astype(x.dtype)


def _t5_bucket(rel):
    nb = REL_BUCKETS // 2
    max_exact = nb // 2
    n = jnp.abs(rel)
    nf = jnp.maximum(n, 1).astype(jnp.float32)
    large = max_exact + (jnp.log(nf / max_exact) / math.log(REL_MAX_DIST / max_exact)
                         * (nb - max_exact)).astype(jnp.int32)
    large = jnp.minimum(large, nb - 1)
    return jnp.where(rel > 0, nb, 0) + jnp.where(n < max_exact, n, large)


def _lambda(lq1, lk1, lq2, lk2, lam_init):
    f = lambda a: a.astype(jnp.float32)
    return jnp.exp(jnp.sum(f(lq1) * f(lk1))) - jnp.exp(jnp.sum(f(lq2) * f(lk2))) + lam_init


def _project(xn, w_in, b_forget):
    B, T, _ = xn.shape
    z = xn @ w_in
    cuts = np.cumsum([DIFF_W, DIFF_W, DIFF_W, FOX_W, FOX_W, FOX_W, N_FOX_HEADS]).tolist()
    qd, kd, vd, qf, kf, vf, fl, gl = jnp.split(z, cuts, axis=-1)
    heads = lambda a: a.reshape(B, T, -1, HEAD_DIM)
    logf = jax.nn.log_sigmoid((fl + b_forget).astype(jnp.float32))
    gates = jax.nn.sigmoid(gl)
    return heads(qd), heads(kd), heads(vd), heads(qf), heads(kf), heads(vf), logf, gates


def _attend(qd, qf, fq, qpos, kd, vd, kf, vf, fk, kpos, rel_table, lam):
    f32 = jnp.float32
    rel = kpos[None, :] - qpos[:, None]
    bias = jnp.transpose(rel_table.astype(f32)[_t5_bucket(rel)], (2, 0, 1))[None]
    chunk_ok = (kpos[None, :] // CHUNK) <= (qpos[:, None] // CHUNK)
    sd = DIFF_QK_DIM ** -0.5
    s1 = jnp.einsum('bqhd,bkhd->bhqk', qd[..., :DIFF_QK_DIM], kd[..., :DIFF_QK_DIM],
                    preferred_element_type=f32) * sd + bias
    s2 = jnp.einsum('bqhd,bkhd->bhqk', qd[..., DIFF_QK_DIM:], kd[..., DIFF_QK_DIM:],
                    preferred_element_type=f32) * sd + bias
    a1 = jax.nn.softmax(jnp.where(chunk_ok, s1, NEG_INF), axis=-1)
    a2 = jax.nn.softmax(jnp.where(chunk_ok, s2, NEG_INF), axis=-1)
    od = jnp.einsum('bhqk,bkhd->bqhd', (a1 - lam * a2).astype(vd.dtype), vd)
    tok_ok = kpos[None, :] <= qpos[:, None]
    decay = jnp.swapaxes(fq, 1, 2)[..., :, None] - jnp.swapaxes(fk, 1, 2)[..., None, :]
    sf = jnp.einsum('bqhd,bkhd->bhqk', qf, kf, preferred_element_type=f32) * HEAD_DIM ** -0.5 + decay
    af = jax.nn.softmax(jnp.where(tok_ok, sf, NEG_INF), axis=-1)
    of = jnp.einsum('bhqk,bkhd->bqhd', af.astype(vf.dtype), vf)
    return od, of


def _prompt_attention(qd, kd, vd, qf, kf, vf, logf, rel_table, lam):
    B, S = qd.shape[:2]
    F = jnp.cumsum(logf, axis=1)
    pos = jnp.arange(S)

    def blk(i):
        qs = i * Q_BLOCK
        sl = lambda a: lax.dynamic_slice_in_dim(a, qs, Q_BLOCK, axis=1)
        return _attend(sl(qd), sl(qf), sl(F), qs + jnp.arange(Q_BLOCK),
                       kd, vd, kf, vf, F, pos, rel_table, lam)

    od, of = lax.map(blk, jnp.arange(S // Q_BLOCK))
    unblock = lambda a: jnp.swapaxes(a, 0, 1).reshape(B, S, a.shape[3], a.shape[4])
    return unblock(od), unblock(of)


def _merge(od, of, gates, subln, lam_init, w_bd, w_bf, w_out):
    B, T = od.shape[:2]
    od = _rms(od, subln) * (1.0 - lam_init)
    yd = od.reshape(B, T, DIFF_W) @ w_bd
    yf = of.reshape(B, T, FOX_W) @ w_bf
    ga, gb = jnp.split(gates, 2, axis=-1)
    return (ga * yd + gb * yf) @ w_out


def _conv_ffn(xn, conv_prev, w_up, conv_w, conv_b, w_down):
    T = xn.shape[1]
    a, b = jnp.split(xn @ w_up, 2, axis=-1)
    a_ext = jnp.concatenate([conv_prev.astype(a.dtype), a], axis=1)
    ac = sum(conv_w[k] * a_ext[:, k:k + T] for k in range(CONV_WIDTH)) + conv_b
    return (jax.nn.gelu(ac, approximate=True) * b) @ w_down, a_ext[:, T:]


def _layer(h, past, rel_table, lam, lam_init, pre1, w_in, b_forget, subln, w_bd, w_bf,
           w_out, post1, pre2, w_up, conv_w, conv_b, w_down, post2):
    B, T, _ = h.shape
    qd, kd, vd, qf, kf, vf, logf, gates = _project(_rms(h, pre1), w_in, b_forget)
    if past is None:
        od, of = _prompt_attention(qd, kd, vd, qf, kf, vf, logf, rel_table, lam)
        conv_prev = jnp.zeros((B, CONV_WIDTH - 1, D_FF), h.dtype)
    else:
        pk, pv, pfk, pfv, plogf, conv_prev = past
        P = pk.shape[1]
        cat = lambda c, n: jnp.concatenate([c.astype(n.dtype), n], axis=1)
        F = jnp.cumsum(jnp.concatenate([plogf.astype(jnp.float32), logf], axis=1), axis=1)
        od, of = _attend(qd, qf, F[:, P:], P + jnp.arange(T), cat(pk, kd), cat(pv, vd),
                         cat(pfk, kf), cat(pfv, vf), F, jnp.arange(P + T), rel_table, lam)
    h = h + _rms(_merge(od, of, gates, subln, lam_init, w_bd, w_bf, w_out), post1)
    ff, conv_state = _conv_ffn(_rms(h, pre2), conv_prev, w_up, conv_w, conv_b, w_down)
    h = h + _rms(ff, post2)
    return h, (kd, vd, kf, vf, logf, conv_state)


def setup_inputs(seed: int = 0) -> dict:
    key = jax.random.key(seed)
    ks = jax.random.split(key, 32)
    nrm = lambda k, shape, s=1.0: s * jax.random.normal(k, shape, jnp.float32)
    gain = lambda k, shape: 1.0 + 0.05 * jax.random.normal(k, shape, jnp.float32)
    return {
        "x_prompt": nrm(ks[0], (BATCH, SEQ, D_MODEL)),
        "x_sample": nrm(ks[1], (DEC_BATCH, DEC_SEQ, D_MODEL)),
        "cache_diff_k": nrm(ks[2], (DEPTH, DEC_BATCH, PAST_LEN, N_DIFF_HEADS, HEAD_DIM)),
        "cache_diff_v": nrm(ks[3], (DEPTH, DEC_BATCH, PAST_LEN, N_DIFF_HEADS, HEAD_DIM)),
        "cache_fox_k": nrm(ks[4], (DEPTH, DEC_BATCH, PAST_LEN, N_FOX_HEADS, HEAD_DIM)),
        "cache_fox_v": nrm(ks[5], (DEPTH, DEC_BATCH, PAST_LEN, N_FOX_HEADS, HEAD_DIM)),
        "cache_fox_logf": jax.nn.log_sigmoid(nrm(ks[6], (DEPTH, DEC_BATCH, PAST_LEN, N_FOX_HEADS))),
        "state_ffn_conv": nrm(ks[7], (DEPTH, DEC_BATCH, CONV_WIDTH - 1, D_FF)),
        "rel_table": nrm(ks[8], (REL_BUCKETS, N_DIFF_HEADS), 0.5),
        "pre_norm1": gain(ks[9], (DEPTH, D_MODEL)),
        "w_in": nrm(ks[10], (DEPTH, D_MODEL, N_IN), D_MODEL ** -0.5),
        "b_forget": nrm(ks[11], (DEPTH, N_FOX_HEADS), 0.1),
        "lam_q1": nrm(ks[12], (DEPTH, DIFF_QK_DIM), 0.1),
        "lam_k1": nrm(ks[13], (DEPTH, DIFF_QK_DIM), 0.1),
        "lam_q2": nrm(ks[14], (DEPTH, DIFF_QK_DIM), 0.1),
        "lam_k2": nrm(ks[15], (DEPTH, DIFF_QK_DIM), 0.1),
        "diff_subln": gain(ks[16], (DEPTH, HEAD_DIM)),
        "w_branch_diff": nrm(ks[17], (DEPTH, DIFF_W, D_MODEL), DIFF_W ** -0.5),
        "w_branch_fox": nrm(ks[18], (DEPTH, FOX_W, D_MODEL), FOX_W ** -0.5),
        "w_out": nrm(ks[19], (DEPTH, D_MODEL, D_MODEL), D_MODEL ** -0.5),
        "post_norm1": gain(ks[20], (DEPTH, D_MODEL)),
        "pre_norm2": gain(ks[21], (DEPTH, D_MODEL)),
        "w_up": nrm(ks[22], (DEPTH, D_MODEL, 2 * D_FF), D_MODEL ** -0.5),
        "conv_w": nrm(ks[23], (DEPTH, CONV_WIDTH, D_FF), CONV_WIDTH ** -0.5),
        "conv_b": nrm(ks[24], (DEPTH, D_FF), 0.01),
        "w_down": nrm(ks[25], (DEPTH, D_FF, D_MODEL), D_FF ** -0.5),
        "post_norm2": gain(ks[26], (DEPTH, D_MODEL)),
    }


def reference(x_prompt, x_sample, cache_diff_k, cache_diff_v, cache_fox_k, cache_fox_v,
              cache_fox_logf, state_ffn_conv, rel_table, pre_norm1, w_in, b_forget,
              lam_q1, lam_k1, lam_q2, lam_k2, diff_subln, w_branch_diff, w_branch_fox,
              w_out, post_norm1, pre_norm2, w_up, conv_w, conv_b, w_down, post_norm2):
    hp, hs = x_prompt, x_sample
    new_p, new_s = [], []
    for l in range(DEPTH):
        lam_init = 0.8 - 0.6 * math.exp(-0.3 * l)
        lam = _lambda(lam_q1[l], lam_k1[l], lam_q2[l], lam_k2[l], lam_init)
        params = (pre_norm1[l], w_in[l], b_forget[l], diff_subln[l], w_branch_diff[l],
                  w_branch_fox[l], w_out[l], post_norm1[l], pre_norm2[l], w_up[l],
                  conv_w[l], conv_b[l], w_down[l], post_norm2[l])
        hp, sp = _layer(hp, None, rel_table, lam, lam_init, *params)
        past = (cache_diff_k[l], cache_diff_v[l], cache_fox_k[l], cache_fox_v[l],
                cache_fox_logf[l], state_ffn_conv[l])
        hs, ss = _layer(hs, past, rel_table, lam, lam_init, *params)
        new_p.append(sp)
        new_s.append(ss)
    st = lambda lst, i: jnp.stack([e[i] for e in lst])
    return (hp, hs,
            st(new_p, 0), st(new_p, 1), st(new_p, 2), st(new_p, 3), st(new_p, 4), st(new_p, 5),
            st(new_s, 0), st(new_s, 1), st(new_s, 2), st(new_s, 3), st(new_s, 4), st(new_s, 5))
```

```cpp
#include <hip/hip_runtime.h>
#include <hip/hip_bf16.h>
#include <hip/hip_cooperative_groups.h>
#include <cstdio>
#include <cstdint>
namespace cg = cooperative_groups;

constexpr int DM = 2048, SEQ = 8192, MP = 16384, MSAMP = 512, MT = 16896, PAST = 1024, DFF = 8192;
constexpr int NIN = 10248, NIN_PAD = 10496;
constexpr float EPS = 1e-6f, LOG2E = 1.4426950408889634f;
constexpr float SC_D = 0.125f * LOG2E, SC_F = 0.08838834764831845f * LOG2E;
constexpr float LAM_INIT = 0.2f;
constexpr size_t O_Y = 0, O_DKP = 34603008, O_DVP = 51380224, O_FKP = 68157440, O_FVP = 84934656, O_LFP = 101711872, O_CVP = 101842944,
                 O_DKS = 101875712, O_DVS = 102400000, O_FKS = 102924288, O_FVS = 103448576, O_LFS = 103972864, O_CVS = 103976960, O_END = 104501248;
constexpr size_t MiB = 1u << 20;
constexpr size_t WS_WT_IN = 0, WS_WT_MRG = 41 * MiB, WS_WT_OUT = 49 * MiB, WS_WT_UP = 57 * MiB, WS_WT_DN = 121 * MiB, WS_XN = 153 * MiB,
                 WS_QKV = 219 * MiB, WS_GATES = 417 * MiB, WS_LOGF = 549 * MiB, WS_ATT = 550 * MiB, WS_T1 = 616 * MiB, WS_G = 682 * MiB,
                 WS_MO = 748 * MiB, WS_HH = 219 * MiB, WS_TAIL = 814 * MiB, WS_HEAD = 819 * MiB, WS_END = 828 * MiB;
constexpr int LDS_BYTES = 155648;
constexpr int MISC_OFF = 155520;
constexpr size_t WS_BAR = 549 * MiB + 800 * 1024, BAR_BYTES = 16384;
constexpr int STG_OFF = 135168;
constexpr int XBUF_OFF = 131072;

#define LAS __attribute__((address_space(3)))
typedef unsigned short bf16_t;
typedef short bf16x8 __attribute__((ext_vector_type(8)));
typedef short s16x4 __attribute__((ext_vector_type(4)));
typedef float f32x4 __attribute__((ext_vector_type(4)));
typedef float f32x2 __attribute__((ext_vector_type(2)));
typedef float f32x16 __attribute__((ext_vector_type(16)));
typedef unsigned u32x4 __attribute__((ext_vector_type(4)));
typedef unsigned u32x2 __attribute__((ext_vector_type(2)));

__device__ __forceinline__ unsigned cvt_pk_bf16(float lo, float hi) { unsigned r; asm volatile("v_cvt_pk_bf16_f32 %0, %1, %2" : "=v"(r) : "v"(lo), "v"(hi)); return r; }
__device__ __forceinline__ float bf2f(unsigned short x) { return __uint_as_float((unsigned)x << 16); }
__device__ __forceinline__ float bflo(unsigned w) { return __uint_as_float(w << 16); }
__device__ __forceinline__ float bfhi(unsigned w) { return __uint_as_float(w & 0xffff0000u); }
__device__ __forceinline__ u32x4 pack8(const f32x4 a, const f32x4 b) { u32x4 w; w.x = cvt_pk_bf16(a[0], a[1]); w.y = cvt_pk_bf16(a[2], a[3]); w.z = cvt_pk_bf16(b[0], b[1]); w.w = cvt_pk_bf16(b[2], b[3]); return w; }
__device__ __forceinline__ void unpack8(const u32x4 w, f32x4& a, f32x4& b) { a = (f32x4){bflo(w.x), bfhi(w.x), bflo(w.y), bfhi(w.y)}; b = (f32x4){bflo(w.z), bfhi(w.z), bflo(w.w), bfhi(w.w)}; }
__device__ __forceinline__ float wave_sum(float v) {
#pragma unroll
    for (int o = 1; o < 64; o <<= 1) v += __shfl_xor(v, o);
    return v;
}
__device__ __forceinline__ float wave_max(float v) {
#pragma unroll
    for (int o = 1; o < 64; o <<= 1) v = fmaxf(v, __shfl_xor(v, o));
    return v;
}
__device__ __forceinline__ float gelu_tanh(float x) {
    const float u2 = 1.5957691216057308f * x * (1.0f + 0.044715f * x * x);
    return x * __builtin_amdgcn_rcpf(1.0f + __builtin_amdgcn_exp2f(-u2 * LOG2E));
}
__device__ __forceinline__ int t5_bucket(int rel) {
    const int n = rel < 0 ? -rel : rel; int v;
    if (n < 8) v = n; else { const int k = (31 - __clz(n * n)) - 6; v = 8 + k; if (v > 15) v = 15; }
    return (rel > 0 ? 16 : 0) + v;
}
template <int CTRL> __device__ __forceinline__ float dppf(float v) { return __builtin_bit_cast(float, __builtin_amdgcn_update_dpp(0, __builtin_bit_cast(int, v), CTRL, 0xf, 0xf, true)); }

namespace pg8 {
#define PG8_LAS __attribute__((address_space(3)))
constexpr int BM = 256, BK = 64, HALF = 128, HTB = HALF * BK * 2  , STAGE_BYTES = 8 * HTB, NXCD = 8, WGM = 8;

__host__ __device__ __forceinline__ int lds_byte(int r, int c) { const int st = (r >> 4) * 2 + (c >> 5), rr = r & 15, cc = c & 31, ob = rr * 64 + cc * 2; return st * 1024 + (ob ^ (((ob >> 9) & 1) << 5)); }
__host__ __device__ __forceinline__ void stage_rc(int b, int& R, int& C) { const int st = b / 1024, sb = b % 1024, swz = sb ^ (((sb >> 9) & 1) << 5); R = (st >> 1) * 16 + swz / 64; C = (st & 1) * 32 + (swz % 64) / 2; }
__host__ __device__ __forceinline__ int perm32(int rho) { const int n = rho >> 4, i = rho & 15; return 8 * (i >> 2) + 4 * n + (i & 3); }

struct Unit { int pm, pn, k0, nt, part; };
struct Gemm { const bf16_t* A; const bf16_t* Bt; int lda, ldb, M, N, K; };

struct StaticOrder {
    int nM, nN, nwg, G, c, ntk;
    __host__ __device__ void init(int M, int N, int G_, int c_, int K) { nM = M / BM; nN = N / BM; nwg = nM * nN; G = G_; c = c_; ntk = K / BK; }
    __host__ __device__ __forceinline__ bool next(int i, Unit& u) const {
        const long L = (long)i * G + c; const bool ok = L < nwg;
        int wgid = ok ? (int)L : nwg - 1; { const int q = nwg / NXCD, r = nwg % NXCD, xcd = wgid % NXCD, off = wgid / NXCD; wgid = (xcd < r ? xcd * (q + 1) : r * (q + 1) + (xcd - r) * q) + off; }
        const int nig = WGM * nN, gid = wgid / nig, fm = gid * WGM, gsz = (nM - fm) < WGM ? (nM - fm) : WGM;
        u.pm = fm + ((wgid % nig) % gsz); u.pn = (wgid % nig) / gsz; u.k0 = 0; u.nt = ntk; u.part = -1; return ok;
    }
    __device__ __forceinline__ void a_ready(const Unit&) const {}
    __device__ __forceinline__ void done(const Unit&) const {}
};

struct SplitOrder {
    StaticOrder P; int RP, K;
    __host__ __device__ void init(int G_, int c_, int K_) { P.init(MP, 2048, G_, c_, K_); RP = (P.nwg + G_ - 1) / G_; K = K_; }
    __host__ __device__ __forceinline__ bool next(int i, Unit& u) const {
        const int np = P.c < P.nwg ? (P.nwg - P.c + P.G - 1) / P.G : 0;
        const bool isP = i < np; Unit a; const bool okA = P.next(isP ? i : 0, a);
        const long idx = (long)(i - np) * P.G + P.c; const bool okB = !isP && idx < 256; const int ii = (int)idx & 255;
        u.pm = isP ? a.pm : 64 + (ii >> 7); u.pn = isP ? a.pn : (ii >> 4) & 7; u.k0 = isP ? 0 : (ii & 15) * (K / 16); u.nt = isP ? P.ntk : K / 16 / BK; u.part = isP ? -1 : (ii & 15);
        return isP ? okA : okB;
    }
    __device__ __forceinline__ void a_ready(const Unit&) const {}
    __device__ __forceinline__ void done(const Unit&) const {}
};


struct EpiIn {
    static constexpr bool PERM = true, AFTER_DRAIN = false;
    bf16_t* qkv; bf16_t* gates; float* logf_ws; float* out; const float* b_forget; float* nrm; PG8_LAS float* stg;
    __device__ __forceinline__ void operator()(const f32x4 (&acc)[2][2][4][2], const Unit& u, int wr, int wc, int fr, int fq) const {
        const int pn = u.pn; const int row0 = u.pm * BM + wr * 64 + fr; const bool samp = u.pm >= 64;
        if (pn < 24) {
            const int grp = pn >> 2; const float sc = grp == 0 ? SC_D : (grp == 3 ? SC_F : 1.f);
            bf16_t* base = qkv + (size_t)grp * MT * 1024; const int col0 = (pn & 3) * 256 + wc * 32 + 8 * fq;
            float* fo = nullptr;
            if (grp == 1) fo = out + (samp ? O_DKS : O_DKP); else if (grp == 2) fo = out + (samp ? O_DVS : O_DVP);
            else if (grp == 4) fo = out + (samp ? O_FKS : O_FKP); else if (grp == 5) fo = out + (samp ? O_FVS : O_FVP);
            PG8_LAS float* st = stg + (wr * 4 + wc) * 576; const int ln = fq * 16 + fr, srow = ln >> 2, sseg = ln & 3;
#pragma unroll
            for (int ai = 0; ai < 2; ++ai)
#pragma unroll
                for (int m = 0; m < 4; ++m) { const int row = row0 + ai * HALF + m * 16;
                    const int g0 = u.pm * BM + ai * HALF + wr * 64 + m * 16 - (samp ? MP : 0);
#pragma unroll
                    for (int bj = 0; bj < 2; ++bj) { const f32x4 v0 = acc[ai][bj][m][0] * sc, v1 = acc[ai][bj][m][1] * sc;
                        *(u32x4*)(base + (size_t)row * 1024 + col0 + bj * HALF) = pack8(v0, v1);
                        if (fo) {
                            *(PG8_LAS f32x4*)(st + fr * 36 + 8 * fq) = v0; *(PG8_LAS f32x4*)(st + fr * 36 + 8 * fq + 4) = v1;
                            asm volatile("s_waitcnt lgkmcnt(0)" ::: "memory");
                            const f32x4 sa = *(const PG8_LAS f32x4*)(st + srow * 36 + 4 * sseg), sb = *(const PG8_LAS f32x4*)(st + srow * 36 + 16 + 4 * sseg);
                            asm volatile("s_waitcnt lgkmcnt(0)" ::: "memory");
                            float* p = fo + (size_t)(g0 + srow) * 1024 + (pn & 3) * 256 + bj * HALF + wc * 32 + 4 * sseg; *(f32x4*)p = sa; *(f32x4*)(p + 16) = sb; } } }
            if ((grp == 3 || grp == 4) && !samp) {
                float mx[2] = {0.f, 0.f};
#pragma unroll
                for (int ai = 0; ai < 2; ++ai)
#pragma unroll
                    for (int m = 0; m < 4; ++m)
#pragma unroll
                        for (int bj = 0; bj < 2; ++bj) { const f32x4 v0 = acc[ai][bj][m][0] * sc, v1 = acc[ai][bj][m][1] * sc;
                            float s = (v0[0] * v0[0] + v0[1] * v0[1]) + (v0[2] * v0[2] + v0[3] * v0[3]) + (v1[0] * v1[0] + v1[1] * v1[1]) + (v1[2] * v1[2] + v1[3] * v1[3]);
                            s += __shfl_xor(s, 16); s += __shfl_xor(s, 32); mx[bj] = fmaxf(mx[bj], s); }
#pragma unroll
                for (int bj = 0; bj < 2; ++bj) {
#pragma unroll
                    for (int o = 1; o < 16; o <<= 1) mx[bj] = fmaxf(mx[bj], __shfl_xor(mx[bj], o));
                    if (fr == 0 && fq == 0) atomicMax((unsigned*)(nrm + (grp == 4 ? 64 : 0) + ((u.pm >> 5) * 8 + 2 * (pn & 3) + bj) * 4 + wc), __float_as_uint(mx[bj])); }
            }
        } else if (pn < 40) {
            const int col0 = (pn - 24) * 256 + wc * 32 + 8 * fq;
#pragma unroll
            for (int ai = 0; ai < 2; ++ai)
#pragma unroll
                for (int m = 0; m < 4; ++m) { const int row = row0 + ai * HALF + m * 16;
#pragma unroll
                    for (int bj = 0; bj < 2; ++bj) { f32x4 v0 = acc[ai][bj][m][0], v1 = acc[ai][bj][m][1];
#pragma unroll
                        for (int i = 0; i < 4; ++i) { v0[i] = __builtin_amdgcn_rcpf(1.f + __builtin_amdgcn_exp2f(-v0[i] * LOG2E)); v1[i] = __builtin_amdgcn_rcpf(1.f + __builtin_amdgcn_exp2f(-v1[i] * LOG2E)); }
                        *(u32x4*)(gates + (size_t)row * 4096 + col0 + bj * HALF) = pack8(v0, v1); } }
        } else {
            if (wc == 0 && fq == 0) {
                const f32x4 b0 = *(const f32x4*)b_forget, b1 = *(const f32x4*)(b_forget + 4);
#pragma unroll
                for (int ai = 0; ai < 2; ++ai)
#pragma unroll
                    for (int m = 0; m < 4; ++m) { const int row = row0 + ai * HALF + m * 16; const int rr = samp ? row - MP : row;
                        f32x4 v0 = acc[ai][0][m][0] + b0, v1 = acc[ai][0][m][1] + b1;
#pragma unroll
                        for (int i = 0; i < 4; ++i) { v0[i] = fminf(v0[i], 0.f) - log1pf(expf(-fabsf(v0[i]))); v1[i] = fminf(v1[i], 0.f) - log1pf(expf(-fabsf(v1[i]))); }
                        *(f32x4*)(logf_ws + (size_t)row * 8) = v0; *(f32x4*)(logf_ws + (size_t)row * 8 + 4) = v1;
                        float* p = out + (samp ? O_LFS : O_LFP) + (size_t)rr * 8; *(f32x4*)p = v0; *(f32x4*)(p + 4) = v1; }
            }
        }
    }
};

template <int STAGE> struct EpiMerge {
    static constexpr bool PERM = true, AFTER_DRAIN = false;
    const bf16_t* gates; bf16_t* t1; bf16_t* g;
    __device__ __forceinline__ void operator()(const f32x4 (&acc)[2][2][4][2], const Unit& u, int wr, int wc, int fr, int fq) const {
        const int row0 = u.pm * BM + wr * 64 + fr, col0 = u.pn * BM + wc * 32 + 8 * fq;
#pragma unroll
        for (int ai = 0; ai < 2; ++ai)
#pragma unroll
            for (int m = 0; m < 4; ++m) { const int row = row0 + ai * HALF + m * 16;
#pragma unroll
                for (int bj = 0; bj < 2; ++bj) { const int c = col0 + bj * HALF;
                    f32x4 g0, g1; unpack8(*(const u32x4*)(gates + (size_t)row * 4096 + STAGE * 2048 + c), g0, g1);
                    f32x4 v0 = acc[ai][bj][m][0] * g0, v1 = acc[ai][bj][m][1] * g1;
                    if (STAGE == 0) { *(u32x4*)(t1 + (size_t)row * 2048 + c) = pack8(v0, v1); }
                    else { f32x4 t0, t1v; unpack8(*(const u32x4*)(t1 + (size_t)row * 2048 + c), t0, t1v); *(u32x4*)(g + (size_t)row * 2048 + c) = pack8(v0 + t0, v1 + t1v); } } }
    }
};

struct EpiPlain {
    static constexpr bool PERM = true, AFTER_DRAIN = false;
    bf16_t* O; int ldc; float* part;
    __device__ __forceinline__ void operator()(const f32x4 (&acc)[2][2][4][2], const Unit& u, int wr, int wc, int fr, int fq) const {
        const int row0 = u.pm * BM + wr * 64 + fr, col0 = u.pn * BM + wc * 32 + 8 * fq;
        if (u.part < 0) {
#pragma unroll
            for (int ai = 0; ai < 2; ++ai)
#pragma unroll
                for (int m = 0; m < 4; ++m) { const int row = row0 + ai * HALF + m * 16;
#pragma unroll
                    for (int bj = 0; bj < 2; ++bj) *(u32x4*)(O + (size_t)row * ldc + col0 + bj * HALF) = pack8(acc[ai][bj][m][0], acc[ai][bj][m][1]); }
        } else {
            float* pb = part + (size_t)u.part * MSAMP * 2048;
#pragma unroll
            for (int ai = 0; ai < 2; ++ai)
#pragma unroll
                for (int m = 0; m < 4; ++m) { const int row = row0 + ai * HALF + m * 16 - MP;
#pragma unroll
                    for (int bj = 0; bj < 2; ++bj) { float* q = pb + (size_t)row * 2048 + col0 + bj * HALF; *(f32x4*)q = acc[ai][bj][m][0]; *(f32x4*)(q + 4) = acc[ai][bj][m][1]; } }
        }
    }
};

struct EpiUp {
    static constexpr bool PERM = true, AFTER_DRAIN = false;
    bf16_t* hh; float* tail; float* head; const float* conv_w; const float* conv_b; const float* state; float* out; PG8_LAS float* xbuf;
    __device__ __forceinline__ void operator()(const f32x4 (&acc)[2][2][4][2], const Unit& u, int wr, int wc, int fr, int fq) const {
        const int cl = wc * 32 + 8 * fq, cgc = u.pn * 128 + cl; const bool samp = u.pm >= 64;
        f32x4 cw0[2], cw1[2], cw2[2], cb[2];
#pragma unroll
        for (int n = 0; n < 2; ++n) { cw0[n] = *(const f32x4*)(conv_w + cgc + 4 * n); cw1[n] = *(const f32x4*)(conv_w + DFF + cgc + 4 * n); cw2[n] = *(const f32x4*)(conv_w + 2 * DFF + cgc + 4 * n); cb[n] = *(const f32x4*)(conv_b + cgc + 4 * n); }
        if (!samp) {
            if (fr >= 14) {
#pragma unroll
                for (int ai = 0; ai < 2; ++ai)
#pragma unroll
                    for (int n = 0; n < 2; ++n) *(PG8_LAS f32x4*)(xbuf + ((ai * 2 + wr) * 2 + (fr - 14)) * 128 + cl + 4 * n) = acc[ai][0][3][n];
            }
            asm volatile("s_waitcnt lgkmcnt(0)" ::: "memory"); __builtin_amdgcn_s_barrier(); asm volatile("" ::: "memory");
        }
#pragma unroll
        for (int ai = 0; ai < 2; ++ai) { const int blk = ai * 2 + wr;
#pragma unroll
            for (int m = 0; m < 4; ++m) {
                const int row = u.pm * BM + ai * HALF + wr * 64 + m * 16 + fr;
                f32x4 w1[2], w2[2];
                if (samp) {
                    const int bs = (row - MP) >> 4;
#pragma unroll
                    for (int n = 0; n < 2; ++n) { const f32x4 s0 = *(const f32x4*)(state + ((size_t)bs * 2 + 0) * DFF + cgc + 4 * n), s1 = *(const f32x4*)(state + ((size_t)bs * 2 + 1) * DFF + cgc + 4 * n);
                        w1[n] = s1; w2[n] = fr == 0 ? s0 : s1; }
                } else if (m == 0) {
                    if (blk > 0) {
#pragma unroll
                        for (int n = 0; n < 2; ++n) { const f32x4 c14 = *(const PG8_LAS f32x4*)(xbuf + ((blk - 1) * 2 + 0) * 128 + cl + 4 * n), c15 = *(const PG8_LAS f32x4*)(xbuf + ((blk - 1) * 2 + 1) * 128 + cl + 4 * n);
                            w1[n] = c15; w2[n] = fr == 0 ? c14 : c15; }
                    } else { w1[0] = w1[1] = w2[0] = w2[1] = (f32x4){0.f, 0.f, 0.f, 0.f}; }
                } else {
#pragma unroll
                    for (int n = 0; n < 2; ++n)
#pragma unroll
                        for (int i = 0; i < 4; ++i) { const float ap = acc[ai][0][m - 1][n][i]; w1[n][i] = dppf<0x10F>(ap); w2[n][i] = dppf<0x10E>(ap); }
                }
                f32x4 hv[2];
#pragma unroll
                for (int n = 0; n < 2; ++n) {
                    const f32x4 a = acc[ai][0][m][n], b = acc[ai][1][m][n];
#pragma unroll
                    for (int i = 0; i < 4; ++i) {
                        const float s1 = dppf<0x111>(a[i]), s2 = dppf<0x112>(a[i]);
                        const float p1 = fr >= 1 ? s1 : w1[n][i], p2 = fr >= 2 ? s2 : w2[n][i];
                        const float ac = cw0[n][i] * p2 + cw1[n][i] * p1 + cw2[n][i] * a[i] + cb[n][i];
                        hv[n][i] = gelu_tanh(ac) * b[i];
                    }
                }
                *(u32x4*)(hh + (size_t)row * DFF + cgc) = pack8(hv[0], hv[1]);
                if (samp) {
                    if (fr >= 14) { const int bs = (row - MP) >> 4; float* p = out + O_CVS + ((size_t)bs * 2 + (fr - 14)) * DFF + cgc; *(f32x4*)p = acc[ai][0][m][0]; *(f32x4*)(p + 4) = acc[ai][0][m][1]; }
                } else {
                    if (blk == 3 && m == 3 && fr >= 14) { float* p = tail + ((size_t)u.pm * 2 + (fr - 14)) * DFF + cgc; *(f32x4*)p = acc[ai][0][m][0]; *(f32x4*)(p + 4) = acc[ai][0][m][1];
                        if ((u.pm & 31) == 31) { float* q = out + O_CVP + ((size_t)(u.pm >> 5) * 2 + (fr - 14)) * DFF + cgc; *(f32x4*)q = acc[ai][0][m][0]; *(f32x4*)(q + 4) = acc[ai][0][m][1]; } }
                    if (blk == 0 && m == 0 && fr < 2) { float* p = head + (((size_t)u.pm * 2 + fr) * 2) * DFF + cgc; *(f32x4*)p = acc[ai][0][m][0]; *(f32x4*)(p + 4) = acc[ai][0][m][1];
                        *(f32x4*)(p + DFF) = acc[ai][1][m][0]; *(f32x4*)(p + DFF + 4) = acc[ai][1][m][1]; }
                }
            }
        }
    }
};

template <class Epi, class Sched, bool ALIGN_EPI = false, bool SP2 = false>
__device__ __forceinline__ void gemm_phase(PG8_LAS unsigned char* lds, const Gemm g, const Sched& S, const Epi& E) {
    const int tid = threadIdx.x, wid = __builtin_amdgcn_readfirstlane(tid >> 6), lane = tid & 63, wr = wid >> 2, wc = wid & 3, fr = lane & 15, fq = lane >> 4;
    const int K = g.K, nt = K / BK;
    unsigned voffA[2], voffB[2];
#pragma unroll
    for (int i = 0; i < 2; ++i) { int R, C; stage_rc(tid * 16 + i * 8192, R, C); const int Rb = Epi::PERM ? ((R & ~31) + perm32(R & 31)) : R;
        voffA[i] = (unsigned)(R * g.lda + C) * 2u; voffB[i] = (unsigned)(Rb * g.ldb + C) * 2u; }
    const size_t kstep = (size_t)(BK * 2);
    const size_t hstepA = (size_t)HALF * g.lda * 2, hstepB = (size_t)HALF * g.ldb * 2;
    const size_t tstepA = 2 * hstepA, tstepB = 2 * hstepB;
    const unsigned ldsw = (unsigned)wid * 1024u;
    const int aoff = lds_byte(wr * 64 + fr, fq * 8), boff = lds_byte(wc * 32 + fr, fq * 8);
#define PG8_SA(b, h) (((b) * 2 + (h)) * HTB)
#define PG8_SB(b, h) ((4 + (b) * 2 + (h)) * HTB)
#define PG8_STAGE(bufoff, gbase, voff) do { _Pragma("unroll") for (int _i = 0; _i < 2; ++_i) \
        __builtin_amdgcn_global_load_lds((const unsigned*)((const char*)(gbase) + (voff)[_i]), (PG8_LAS unsigned*)(lds + (bufoff) + ldsw + _i * 8192), 16, 0, 0); } while (0)
#define PG8_LDA(dst, b, h) do { _Pragma("unroll") for (int m = 0; m < 4; ++m) _Pragma("unroll") for (int k = 0; k < 2; ++k) dst[m][k] = *(const PG8_LAS bf16x8*)(lds + PG8_SA(b, h) + aoff + m * 2048 + k * 1024); } while (0)
#define PG8_LDB(dst, b, h) do { _Pragma("unroll") for (int n = 0; n < 2; ++n) _Pragma("unroll") for (int k = 0; k < 2; ++k) dst[n][k] = *(const PG8_LAS bf16x8*)(lds + PG8_SB(b, h) + boff + n * 2048 + k * 1024); } while (0)
#define PG8_MMA(ai, bj, At, Bt) do { __builtin_amdgcn_s_setprio(1); _Pragma("unroll") for (int m = 0; m < 4; ++m) _Pragma("unroll") for (int n = 0; n < 2; ++n) _Pragma("unroll") for (int k = 0; k < 2; ++k) \
        acc[ai][bj][m][n] = __builtin_amdgcn_mfma_f32_16x16x32_bf16(Bt[n][k], At[m][k], acc[ai][bj][m][n], 0, 0, 0); __builtin_amdgcn_s_setprio(0); } while (0)
#define PG8_WAIT_V(n) asm volatile("s_waitcnt vmcnt(" #n ")" ::: "memory")
#define PG8_WAIT_L(n) asm volatile("s_waitcnt lgkmcnt(" #n ")" ::: "memory")
#define PG8_BAR __builtin_amdgcn_s_barrier()
#define PG8_SCHED __builtin_amdgcn_sched_barrier(0)
    Unit cur, nxt; int ui = 0;
    if (!S.next(0, cur)) return;
    f32x4 acc[2][2][4][2];
#pragma unroll
    for (int a = 0; a < 2; ++a)
#pragma unroll
        for (int b = 0; b < 2; ++b)
#pragma unroll
            for (int m = 0; m < 4; ++m)
#pragma unroll
                for (int n = 0; n < 2; ++n) acc[a][b][m][n] = (f32x4){0.f, 0.f, 0.f, 0.f};
    bf16x8 At[4][2], B0[2][2], B1[2][2];
    const char* cA = (const char*)g.A + (size_t)cur.pm * tstepA + (size_t)cur.k0 * 2; const char* cB = (const char*)g.Bt + (size_t)cur.pn * tstepB + (size_t)cur.k0 * 2;
    S.a_ready(cur);
    if constexpr (SP2) {
        PG8_STAGE(PG8_SB(0, 0), cB, voffB); PG8_STAGE(PG8_SB(0, 1), cB + hstepB, voffB); PG8_STAGE(PG8_SA(0, 0), cA, voffA); PG8_STAGE(PG8_SA(0, 1), cA + hstepA, voffA);
        if (wr == 1) PG8_BAR;
        PG8_WAIT_V(2); PG8_BAR;
        PG8_STAGE(PG8_SB(1, 0), cB + kstep, voffB); PG8_STAGE(PG8_SA(1, 0), cA + kstep, voffA); PG8_STAGE(PG8_SB(1, 1), cB + hstepB + kstep, voffB);
        PG8_WAIT_V(6); PG8_BAR;
    } else {
        PG8_STAGE(PG8_SB(0, 0), cB, voffB); PG8_STAGE(PG8_SA(0, 0), cA, voffA); PG8_STAGE(PG8_SB(0, 1), cB + hstepB, voffB); PG8_STAGE(PG8_SA(0, 1), cA + hstepA, voffA);
        if (wr == 1) PG8_BAR;
        PG8_WAIT_V(4); PG8_BAR;
        PG8_STAGE(PG8_SB(1, 0), cB + kstep, voffB); PG8_STAGE(PG8_SA(1, 0), cA + kstep, voffA); PG8_STAGE(PG8_SB(1, 1), cB + hstepB + kstep, voffB);
        PG8_WAIT_V(6); PG8_BAR;
    }
    for (;;) {
        const bool has_next = S.next(ui + 1, nxt);
        const char* nA = has_next ? (const char*)g.A + (size_t)nxt.pm * tstepA + (size_t)nxt.k0 * 2 : cA; const char* nB = has_next ? (const char*)g.Bt + (size_t)nxt.pn * tstepB + (size_t)nxt.k0 * 2 : cB;
        const int ntc = cur.nt;
        for (int t = 0; t < ntc; t += 2) {
            const bool last = (t == ntc - 2);
            const char* a1 = cA + (size_t)(t + 1) * kstep;
            const char* a2 = last ? nA : cA + (size_t)(t + 2) * kstep; const char* b2 = last ? nB : cB + (size_t)(t + 2) * kstep;
            const char* a3 = a2 + kstep; const char* b3 = b2 + kstep;
            if (last && has_next) S.a_ready(nxt);
            if constexpr (SP2) {
            PG8_LDB(B0, 0, 0); PG8_LDB(B1, 0, 1); PG8_SCHED; PG8_LDA(At, 0, 0); PG8_STAGE(PG8_SA(1, 1), a1 + hstepA, voffA);
            PG8_WAIT_V(8); PG8_WAIT_L(0); PG8_BAR; PG8_MMA(0, 0, At, B0); PG8_MMA(0, 1, At, B1); PG8_BAR; PG8_SCHED;
            PG8_LDA(At, 0, 1); PG8_STAGE(PG8_SB(0, 0), b2, voffB); PG8_STAGE(PG8_SB(0, 1), b2 + hstepB, voffB); PG8_STAGE(PG8_SA(0, 0), a2, voffA);
            PG8_WAIT_V(8); PG8_WAIT_L(0); PG8_BAR; PG8_MMA(1, 0, At, B0); PG8_MMA(1, 1, At, B1); PG8_BAR; PG8_SCHED;
            PG8_LDB(B0, 1, 0); PG8_LDB(B1, 1, 1); PG8_SCHED; PG8_LDA(At, 1, 0); PG8_STAGE(PG8_SA(0, 1), a2 + hstepA, voffA);
            PG8_WAIT_V(8); PG8_WAIT_L(0); PG8_BAR; PG8_MMA(0, 0, At, B0); PG8_MMA(0, 1, At, B1); PG8_BAR; PG8_SCHED;
            PG8_LDA(At, 1, 1); PG8_STAGE(PG8_SB(1, 0), b3, voffB); PG8_STAGE(PG8_SB(1, 1), b3 + hstepB, voffB); PG8_STAGE(PG8_SA(1, 0), a3, voffA);
            PG8_WAIT_V(8); PG8_WAIT_L(0); PG8_BAR; PG8_MMA(1, 0, At, B0); PG8_MMA(1, 1, At, B1); PG8_BAR; PG8_SCHED;
            } else {
            PG8_LDB(B0, 0, 0); PG8_SCHED; PG8_LDA(At, 0, 0); PG8_STAGE(PG8_SA(1, 1), a1 + hstepA, voffA);
            PG8_WAIT_L(8); PG8_BAR; PG8_WAIT_L(0); PG8_MMA(0, 0, At, B0); PG8_BAR; PG8_SCHED;
            PG8_LDB(B1, 0, 1); PG8_STAGE(PG8_SB(0, 0), b2, voffB);
            PG8_BAR; PG8_WAIT_L(0); PG8_MMA(0, 1, At, B1); PG8_BAR;
            PG8_LDA(At, 0, 1); PG8_STAGE(PG8_SA(0, 0), a2, voffA);
            PG8_BAR; PG8_WAIT_L(0); PG8_MMA(1, 0, At, B0); PG8_BAR; PG8_SCHED;
            PG8_STAGE(PG8_SB(0, 1), b2 + hstepB, voffB);
            PG8_WAIT_V(6); PG8_BAR; PG8_MMA(1, 1, At, B1); PG8_BAR;
            PG8_LDB(B0, 1, 0); PG8_SCHED; PG8_LDA(At, 1, 0); PG8_STAGE(PG8_SA(0, 1), a2 + hstepA, voffA);
            PG8_WAIT_L(8); PG8_BAR; PG8_WAIT_L(0); PG8_MMA(0, 0, At, B0); PG8_BAR; PG8_SCHED;
            PG8_LDB(B1, 1, 1); PG8_STAGE(PG8_SB(1, 0), b3, voffB);
            PG8_BAR; PG8_WAIT_L(0); PG8_MMA(0, 1, At, B1); PG8_BAR;
            PG8_LDA(At, 1, 1); PG8_STAGE(PG8_SA(1, 0), a3, voffA);
            PG8_BAR; PG8_WAIT_L(0); PG8_MMA(1, 0, At, B0); PG8_BAR; PG8_SCHED;
            PG8_STAGE(PG8_SB(1, 1), b3 + hstepB, voffB);
            PG8_WAIT_V(6); PG8_BAR; PG8_MMA(1, 1, At, B1); PG8_BAR;
            }
        }
        if constexpr (ALIGN_EPI) { if (wr == 0) PG8_BAR; }
        if constexpr (!Epi::AFTER_DRAIN) { E(acc, cur, wr, wc, fr, fq); S.done(cur); }
        if (!has_next) break;
#pragma unroll
        for (int a = 0; a < 2; ++a)
#pragma unroll
            for (int b = 0; b < 2; ++b)
#pragma unroll
                for (int m = 0; m < 4; ++m)
#pragma unroll
                    for (int n = 0; n < 2; ++n) acc[a][b][m][n] = (f32x4){0.f, 0.f, 0.f, 0.f};
        cur = nxt; cA = nA; cB = nB; ++ui;
        if constexpr (ALIGN_EPI) { if (wr == 1) PG8_BAR; }
    }
    PG8_WAIT_V(0);
    if constexpr (!ALIGN_EPI) { if (wr == 0) PG8_BAR; }
    PG8_BAR;
    if constexpr (Epi::AFTER_DRAIN) { E.fused(acc, cur, wr, wc, fr, fq, lds, wid, lane); S.done(cur); }
#undef PG8_SA
#undef PG8_SB
#undef PG8_STAGE
#undef PG8_LDA
#undef PG8_LDB
#undef PG8_MMA
#undef PG8_WAIT_V
#undef PG8_WAIT_L
#undef PG8_BAR
#undef PG8_SCHED
}
}

namespace att {
constexpr int SHM_V = 16384, SHM_K = 16384;
constexpr int OFF_V = 0, OFF_K = 32768, OFF_WS = 65536, OFF_LUT = 67584, OFF_G = 69632, OFF_XCH = 0;
constexpr float THR = 8.f;
#define KSWZ(row, colB) ((row) * 256 + ((colB) ^ (((row) & 7) << 4)))
#define SBAR() __builtin_amdgcn_sched_barrier(0)
__device__ __forceinline__ int crow(int r, int hi) { return (r & 3) + 8 * (r >> 2) + 4 * hi; }
__device__ __forceinline__ int v_st(int k, int c) { const int kk = (k & ~0xC) | ((k & 4) << 1) | ((k & 8) >> 1); return ((kk >> 3) * 4 + (c >> 5)) * 512 + ((kk & 7) * 32 + (c & 31)) * 2; }
__device__ __forceinline__ int v_rd_base(int lane) { return ((lane & 3) << 3) | (((lane >> 2) & 3) << 6) | (((lane >> 4) & 1) << 5) | (((lane >> 5) & 1) << 8); }
constexpr int v_rd_off(int d0, int ks, int half) { return d0 * 512 + ks * 4096 + half * 2048; }
template <int OFF> __device__ __forceinline__ s16x4 tr_read(int vb) { s16x4 r; asm volatile("ds_read_b64_tr_b16 %0, %1 offset:%2" : "=&v"(r) : "v"(vb), "i"(OFF) : "memory"); return r; }
template <int D0> __device__ __forceinline__ void pv_one(f32x16& od, int vb, bf16x8 pa0, bf16x8 pa1, bf16x8 pa2, bf16x8 pa3) {
  const s16x4 l0 = tr_read<v_rd_off(D0, 0, 0)>(vb), h0 = tr_read<v_rd_off(D0, 0, 1)>(vb), l1 = tr_read<v_rd_off(D0, 1, 0)>(vb), h1 = tr_read<v_rd_off(D0, 1, 1)>(vb);
  const s16x4 l2 = tr_read<v_rd_off(D0, 2, 0)>(vb), h2 = tr_read<v_rd_off(D0, 2, 1)>(vb), l3 = tr_read<v_rd_off(D0, 3, 0)>(vb), h3 = tr_read<v_rd_off(D0, 3, 1)>(vb);
  asm volatile("s_waitcnt lgkmcnt(0)" ::: "memory"); SBAR();
#define PK(L, H) (bf16x8){L[0], L[1], L[2], L[3], H[0], H[1], H[2], H[3]}
  od = __builtin_amdgcn_mfma_f32_32x32x16_bf16(pa0, PK(l0, h0), od, 0, 0, 0);
  od = __builtin_amdgcn_mfma_f32_32x32x16_bf16(pa1, PK(l1, h1), od, 0, 0, 0);
  od = __builtin_amdgcn_mfma_f32_32x32x16_bf16(pa2, PK(l2, h2), od, 0, 0, 0);
  od = __builtin_amdgcn_mfma_f32_32x32x16_bf16(pa3, PK(l3, h3), od, 0, 0, 0);
#undef PK
}

template <int KS> __device__ __forceinline__ void pv_ks(f32x16 (&o)[4], int vb, bf16x8 pa) {
  const s16x4 l0 = tr_read<v_rd_off(0, KS, 0)>(vb), h0 = tr_read<v_rd_off(0, KS, 1)>(vb), l1 = tr_read<v_rd_off(1, KS, 0)>(vb), h1 = tr_read<v_rd_off(1, KS, 1)>(vb);
  const s16x4 l2 = tr_read<v_rd_off(2, KS, 0)>(vb), h2 = tr_read<v_rd_off(2, KS, 1)>(vb), l3 = tr_read<v_rd_off(3, KS, 0)>(vb), h3 = tr_read<v_rd_off(3, KS, 1)>(vb);
  asm volatile("s_waitcnt lgkmcnt(0)" ::: "memory"); SBAR();
#define PK(L, H) (bf16x8){L[0], L[1], L[2], L[3], H[0], H[1], H[2], H[3]}
  o[0] = __builtin_amdgcn_mfma_f32_32x32x16_bf16(pa, PK(l0, h0), o[0], 0, 0, 0);
  o[1] = __builtin_amdgcn_mfma_f32_32x32x16_bf16(pa, PK(l1, h1), o[1], 0, 0, 0);
  o[2] = __builtin_amdgcn_mfma_f32_32x32x16_bf16(pa, PK(l2, h2), o[2], 0, 0, 0);
  o[3] = __builtin_amdgcn_mfma_f32_32x32x16_bf16(pa, PK(l3, h3), o[3], 0, 0, 0);
#undef PK
}

struct AttnP { const bf16_t* qkv; const float* logf; bf16_t* att; const float* rel_table; const float* subln; };

template <int MODE>
__device__ __forceinline__ void attn_unit(const AttnP& P, int b, int h, int u, int j0, char* lds, float lam) {
  constexpr int NQ = MODE == 0 ? 4 : 8;
  const int tid = threadIdx.x, wid = tid >> 6, lane = tid & 63, r32 = lane & 31, hi = lane >> 5;
  const long rowbase = (long)b * SEQ;
  const int qg = wid >> 1, map = wid & 1;
  const int qw = MODE == 0 ? 128 * u + 32 * qg : 256 * u + 32 * wid;
  const int NT = MODE == 0 ? 2 * u + 2 : 4 * u + 4;
  const int NTw = MODE == 0 ? 2 * u + 1 + (qg >> 1) : 4 * u + (wid >> 1) + 1;
  const int kcolB = MODE == 0 ? map * 128 : 0;
  const bf16_t* Qb = P.qkv + (size_t)(MODE == 0 ? 0 : 3) * MT * 1024;
  const bf16_t* Kh = P.qkv + (size_t)(MODE == 0 ? 1 : 4) * MT * 1024 + rowbase * 1024 + h * 128;
  const bf16_t* Vh = P.qkv + (size_t)(MODE == 0 ? 2 : 5) * MT * 1024 + rowbase * 1024 + h * 128;
  char* V_lds = lds + OFF_V; char* K_lds = lds + OFF_K;
  float* wsf = (float*)(lds + OFF_WS) + wid * 64; float* li_l = wsf; float* al_l = wsf + 32;
  const float* lut = (const float*)(lds + OFF_LUT); const float* Gl = (const float*)(lds + OFF_G);
  bf16x8 qr[NQ];
  { const bf16_t* Qw = Qb + (rowbase + qw + r32) * 1024 + h * 128 + (MODE == 0 ? map * 64 : 0) + hi * 8;
#pragma unroll
    for (int d0 = 0; d0 < NQ; ++d0) qr[d0] = *(const bf16x8*)(Qw + d0 * 16); }
  const int sr = tid >> 4, sc = (tid & 15) * 8, vst0 = v_st(sr, sc), vst1 = v_st(32 + sr, sc);
  const int vb0 = (int)(uintptr_t)V_lds + v_rd_base(lane);
  bf16x8 vs0, vs1, ks0, ks1;
#define SLOAD(k0) do { vs0 = *(const bf16x8*)(Vh + (long)((k0) + sr) * 1024 + sc); vs1 = *(const bf16x8*)(Vh + (long)((k0) + 32 + sr) * 1024 + sc); \
    ks0 = *(const bf16x8*)(Kh + (long)((k0) + sr) * 1024 + sc); ks1 = *(const bf16x8*)(Kh + (long)((k0) + 32 + sr) * 1024 + sc); } while (0)
#define SWRITE(bb) do { *(bf16x8*)(V_lds + (bb) * SHM_V + vst0) = vs0; *(bf16x8*)(V_lds + (bb) * SHM_V + vst1) = vs1; const int kc = sc * 2; \
    *(bf16x8*)(K_lds + (bb) * SHM_K + KSWZ(sr, kc)) = ks0; *(bf16x8*)(K_lds + (bb) * SHM_K + KSWZ(32 + sr, kc)) = ks1; } while (0)
  float mref = 0.f, l_reg = 0.f; f32x16 o[4], negm;
#pragma unroll
  for (int d = 0; d < 4; ++d) o[d] = f32x16{};
  float b15 = 0.f; if (MODE == 0) b15 = P.rel_table[15 * 8 + h] * LOG2E;
#pragma unroll
  for (int r = 0; r < 16; ++r) negm[r] = b15;
  SLOAD(j0 * 64); SWRITE(j0 & 1); if (j0 + 1 < NT) SLOAD((j0 + 1) * 64);
  __syncthreads();
  for (int j = j0; j < NT; ++j) {
    const int buf = j & 1;
    if (j < NTw) {
      f32x16 p0, p1;
      const bool far = (MODE == 0) && (j * 64 + 63 <= qw - 128);
      if (far) { p0 = negm; p1 = negm; }
      else if (MODE == 0) { const int idx0 = j * 64 - (qw + r32) + 255;
#pragma unroll
        for (int r = 0; r < 16; ++r) { p0[r] = lut[idx0 + crow(r, hi)] - mref; p1[r] = lut[idx0 + 32 + crow(r, hi)] - mref; }
      } else {
#pragma unroll
        for (int r = 0; r < 16; ++r) { p0[r] = Gl[j * 64 + crow(r, hi)] - mref; p1[r] = Gl[j * 64 + 32 + crow(r, hi)] - mref; }
      }
      const char* Ks = K_lds + buf * SHM_K;
#pragma unroll
      for (int d0 = 0; d0 < NQ; ++d0) { const int cb = kcolB + (d0 * 16 + hi * 8) * 2;
        const bf16x8 k0 = *(const bf16x8*)(Ks + KSWZ(r32, cb)); const bf16x8 k1 = *(const bf16x8*)(Ks + KSWZ(32 + r32, cb));
        p0 = __builtin_amdgcn_mfma_f32_32x32x16_bf16(k0, qr[d0], p0, 0, 0, 0);
        p1 = __builtin_amdgcn_mfma_f32_32x32x16_bf16(k1, qr[d0], p1, 0, 0, 0); }
      if (MODE == 1) {
        if (j * 64 + 63 > qw) { const int qq = qw + r32;
#pragma unroll
          for (int r = 0; r < 16; ++r) { const int key = j * 64 + crow(r, hi); if (key > qq) p0[r] = -1e30f; if (key + 32 > qq) p1[r] = -1e30f; }
        }
      }
#define PK4(Pv, BASE, OUT) do { unsigned a0 = cvt_pk_bf16(Pv[BASE + 0], Pv[BASE + 1]), a1 = cvt_pk_bf16(Pv[BASE + 2], Pv[BASE + 3]);   \
    unsigned b0 = cvt_pk_bf16(Pv[BASE + 4], Pv[BASE + 5]), b1 = cvt_pk_bf16(Pv[BASE + 6], Pv[BASE + 7]);                              \
    auto r0 = __builtin_amdgcn_permlane32_swap(a0, b0, false, false); auto r1 = __builtin_amdgcn_permlane32_swap(a1, b1, false, false); \
    u32x4 w = {r0[0], r1[0], r0[1], r1[1]}; OUT = *reinterpret_cast<bf16x8*>(&w); } while (0)
#define SM_HALF(PV, PO, ADJ, PAa, PAb) do { \
      float pm_ = PV[0]; \
      _Pragma("unroll") for (int r = 1; r < 16; ++r) pm_ = fmaxf(pm_, PV[r]); \
      { auto rr = __builtin_amdgcn_permlane32_swap(__float_as_uint(pm_), __float_as_uint(pm_), false, false); pm_ = fmaxf(__uint_as_float(rr[0]), __uint_as_float(rr[1])); } \
      if (__any(pm_ > THR)) { const float dl = fmaxf(pm_, 0.f); mref += dl; \
        _Pragma("unroll") for (int r = 0; r < 16; ++r) { PV[r] -= dl; if (ADJ) PO[r] -= dl; if (MODE == 0) negm[r] -= dl; } \
        const float f = __builtin_amdgcn_exp2f(-dl); l_reg *= f; \
        if (hi == 0) al_l[r32] = f; asm volatile("s_waitcnt lgkmcnt(0)" ::: "memory"); \
        _Pragma("unroll") for (int r = 0; r < 16; ++r) { const float fr_ = al_l[crow(r, hi)]; \
          _Pragma("unroll") for (int d = 0; d < 4; ++d) o[d][r] *= fr_; } } \
      _Pragma("unroll") for (int r = 0; r < 16; ++r) PV[r] = __builtin_amdgcn_exp2f(PV[r]); \
      { float ps = PV[0]; \
        _Pragma("unroll") for (int r = 1; r < 16; ++r) ps += PV[r]; \
        auto rr = __builtin_amdgcn_permlane32_swap(__float_as_uint(ps), __float_as_uint(ps), false, false); l_reg += __uint_as_float(rr[0]) + __uint_as_float(rr[1]); } \
      PK4(PV, 0, PAa); PK4(PV, 8, PAb); } while (0)
      const int vb = vb0 + buf * SHM_V;
      bf16x8 pa0, pa1, pa2, pa3;
      SM_HALF(p0, p1, 1, pa0, pa1);
      pv_ks<0>(o, vb, pa0); pv_ks<1>(o, vb, pa1);
      SM_HALF(p1, p0, 0, pa2, pa3);
      pv_ks<2>(o, vb, pa2); pv_ks<3>(o, vb, pa3);
#undef SM_HALF
#undef PK4
    }
    if (j + 1 < NT) { SWRITE(buf ^ 1); if (j + 2 < NT) SLOAD((j + 2) * 64); }
    __syncthreads();
  }
#undef SLOAD
#undef SWRITE
  if (hi == 0) li_l[r32] = l_reg; asm volatile("s_waitcnt lgkmcnt(0)" ::: "memory");
  float rli[16];
#pragma unroll
  for (int r = 0; r < 16; ++r) rli[r] = __builtin_amdgcn_rcpf(li_l[crow(r, hi)]);
  if (MODE == 1) {
    bf16_t* Ow = P.att + (size_t)(rowbase + qw) * 2048 + 1024 + h * 128 + r32;
#pragma unroll
    for (int r = 0; r < 16; ++r) { const int orow = crow(r, hi);
#pragma unroll
      for (int d0 = 0; d0 < 4; ++d0) Ow[(size_t)orow * 2048 + d0 * 32] = (bf16_t)(cvt_pk_bf16(o[d0][r] * rli[r], 0.f) & 0xffffu); }
  } else {
    float* xo = (float*)(lds + (map ? OFF_XCH : OFF_G)) + qg * (32 * 128);
#pragma unroll
    for (int r = 0; r < 16; ++r) { const int orow = crow(r, hi);
#pragma unroll
      for (int d0 = 0; d0 < 4; ++d0) xo[orow * 128 + d0 * 32 + r32] = o[d0][r] * rli[r]; }
    __syncthreads();
    { const int row = tid >> 2, q4 = tid & 3;
      const float* x1 = (const float*)(lds + OFF_G) + row * 128 + 32 * q4; const float* x2 = (const float*)(lds + OFF_XCH) + row * 128 + 32 * q4;
      f32x4 v[8]; float ss = 0.f;
#pragma unroll
      for (int i = 0; i < 8; ++i) { v[i] = *(const f32x4*)(x1 + 4 * i) - lam * *(const f32x4*)(x2 + 4 * i); ss += (v[i].x * v[i].x + v[i].y * v[i].y) + (v[i].z * v[i].z + v[i].w * v[i].w); }
      ss += __shfl_xor(ss, 1); ss += __shfl_xor(ss, 2);
      const float rs = rsqrtf(ss * (1.f / 128.f) + EPS) * (1.f - LAM_INIT);
      bf16_t* Ow = P.att + (size_t)(rowbase + 128 * u + row) * 2048 + h * 128 + 32 * q4;
#pragma unroll
      for (int i = 0; i < 4; ++i) { const f32x4 s0 = *(const f32x4*)(P.subln + 32 * q4 + 8 * i), s1 = *(const f32x4*)(P.subln + 32 * q4 + 8 * i + 4);
        *(u32x4*)(Ow + 8 * i) = pack8(v[2 * i] * s0 * rs, v[2 * i + 1] * s1 * rs); } }
    __syncthreads();
  }
}

__device__ __forceinline__ int fox_setup(const float* logf, const float* nrm, int b, int h, int q0, char* lds) {
  const int tid = threadIdx.x, wid = tid >> 6, lane = tid & 63;
  float* Gl = (float*)(lds + OFF_G); float* wt = (float*)(lds + OFF_WS);
  const float* src = logf + ((size_t)b * SEQ + (size_t)tid * 16) * 8 + h;
  float loc[16]; float s = 0.f;
#pragma unroll
  for (int i = 0; i < 16; ++i) { s += src[i * 8]; loc[i] = s; }
  float inc = s;
#pragma unroll
  for (int o = 1; o < 64; o <<= 1) { const float t = __shfl_up(inc, o); if (lane >= o) inc += t; }
  __syncthreads();
  if (lane == 63) wt[wid] = inc;
  __syncthreads();
  float off = inc - s;
  for (int w = 0; w < wid; ++w) off += wt[w];
#pragma unroll
  for (int i = 0; i < 16; ++i) Gl[tid * 16 + i] = (off + loc[i]) * LOG2E;
  __syncthreads();
  const float fref = Gl[q0];
  __syncthreads();
#pragma unroll
  for (int i = 0; i < 16; ++i) Gl[tid * 16 + i] = fref - Gl[tid * 16 + i];
  __syncthreads();
  const float* nq = nrm + (b * 8 + h) * 4; const float* nk = nrm + 64 + (b * 8 + h) * 4;
  const float smax = sqrtf((nq[0] + nq[1]) + (nq[2] + nq[3])) * sqrtf((nk[0] + nk[1]) + (nk[2] + nk[3])) * 1.02f;
  const float thr = -(2.f * smax + 64.f);
  int lo = 0, hi = q0 >> 6;
  while (lo < hi) { const int mid = (lo + hi) >> 1; if (Gl[mid * 64 + 63] > thr) hi = mid; else lo = mid + 1; }
  return __builtin_amdgcn_readfirstlane(lo);
}
__device__ __forceinline__ void diff_setup(const float* rel_table, int h, char* lds) {
  float* lut = (float*)(lds + OFF_LUT);
  __syncthreads();
  for (int i = threadIdx.x; i < 320; i += 512) lut[i] = rel_table[t5_bucket(i - 255) * 8 + h] * LOG2E;
  __syncthreads();
}
#undef SBAR
}

namespace smp {
constexpr int SST = 1056;
constexpr int OFF_S1 = 0, OFF_S2 = 67584, OFF_F = 135168, OFF_RED = 67584;
struct SampP { const bf16_t* qkv; const float* logf; const float* ck[2]; const float* cv[2]; const float* clogf; bf16_t* att; const float* rel_table; const float* subln; };

__device__ __forceinline__ bf16x8 ld8f(const float* p) { const f32x4 a = *(const f32x4*)p, b = *(const f32x4*)(p + 4); const u32x4 w = pack8(a, b); return __builtin_bit_cast(bf16x8, w); }

template <int BR>
__device__ __forceinline__ void sample_unit(const SampP& P, int bs, int h, char* lds, float lam) {
  const int tid = threadIdx.x, wid = tid >> 6, lane = tid & 63, l15 = lane & 15, g = lane >> 4;
  float* S1 = (float*)(lds + OFF_S1); float* S2 = (float*)(lds + OFF_S2); float* Fl = (float*)(lds + OFF_F); float* red = (float*)(lds + OFF_RED);
  const size_t qrow = (size_t)MP + bs * 16;
  const bf16_t* Qb = P.qkv + (size_t)(BR == 0 ? 0 : 3) * MT * 1024 + (qrow + l15) * 1024 + h * 128 + 8 * g;
  const bf16_t* Kn = P.qkv + (size_t)(BR == 0 ? 1 : 4) * MT * 1024 + qrow * 1024 + h * 128;
  const bf16_t* Vn = P.qkv + (size_t)(BR == 0 ? 2 : 5) * MT * 1024 + qrow * 1024 + h * 128;
  const float* Kc = P.ck[BR] + ((size_t)bs * PAST * 8 + h) * 128;
  const float* Vc = P.cv[BR] + ((size_t)bs * PAST * 8 + h) * 128;
  bf16x8 qf[4];
#pragma unroll
  for (int s = 0; s < 4; ++s) qf[s] = *(const bf16x8*)(Qb + 32 * s);
  __syncthreads();
  if (BR == 1) {
    if (wid == 0) {
      float loc[17]; float s = 0.f;
#pragma unroll
      for (int i = 0; i < 17; ++i) { const int j = lane * 17 + i; float v = 0.f;
        if (j < PAST) v = P.clogf[((size_t)bs * PAST + j) * 8 + h]; else if (j < PAST + 16) v = P.logf[(qrow + (j - PAST)) * 8 + h];
        s += v; loc[i] = s; }
      float inc = s;
#pragma unroll
      for (int o = 1; o < 64; o <<= 1) { const float t = __shfl_up(inc, o); if (lane >= o) inc += t; }
      const float off = inc - s;
#pragma unroll
      for (int i = 0; i < 17; ++i) { const int j = lane * 17 + i; if (j < PAST + 16) Fl[j] = (off + loc[i]) * LOG2E; }
    }
    __syncthreads();
  }
#define LOADK(KF, kb_) do { if ((kb_) < 64) { const float* kp = Kc + (size_t)(16 * (kb_) + l15) * 1024 + 8 * g; \
      _Pragma("unroll") for (int s = 0; s < 4; ++s) KF[s] = ld8f(kp + 32 * s); } \
    else { const bf16_t* kp = Kn + (size_t)l15 * 1024 + 8 * g; _Pragma("unroll") for (int s = 0; s < 4; ++s) KF[s] = *(const bf16x8*)(kp + 32 * s); } } while (0)
#define SCOREK(KF, kb_) do { const int key0 = 16 * (kb_) + 4 * g; \
    if (BR == 1) { f32x4 a = {0.f, 0.f, 0.f, 0.f}; \
      _Pragma("unroll") for (int s = 0; s < 4; ++s) a = __builtin_amdgcn_mfma_f32_16x16x32_bf16(KF[s], qf[s], a, 0, 0, 0); \
      const float fq = Fl[PAST + l15]; \
      _Pragma("unroll") for (int i = 0; i < 4; ++i) { const int key = key0 + i; a[i] = key > PAST + l15 ? -1e30f : a[i] + (fq - Fl[key]); } \
      *(f32x4*)(S1 + l15 * SST + key0) = a; \
    } else { f32x4 a1 = {0.f, 0.f, 0.f, 0.f}, a2 = {0.f, 0.f, 0.f, 0.f}; \
      a1 = __builtin_amdgcn_mfma_f32_16x16x32_bf16(KF[0], qf[0], a1, 0, 0, 0); a1 = __builtin_amdgcn_mfma_f32_16x16x32_bf16(KF[1], qf[1], a1, 0, 0, 0); \
      a2 = __builtin_amdgcn_mfma_f32_16x16x32_bf16(KF[2], qf[2], a2, 0, 0, 0); a2 = __builtin_amdgcn_mfma_f32_16x16x32_bf16(KF[3], qf[3], a2, 0, 0, 0); \
      _Pragma("unroll") for (int i = 0; i < 4; ++i) { const float bias = P.rel_table[t5_bucket(key0 + i - (PAST + l15)) * 8 + h] * LOG2E; a1[i] += bias; a2[i] += bias; } \
      *(f32x4*)(S1 + l15 * SST + key0) = a1; *(f32x4*)(S2 + l15 * SST + key0) = a2; } } while (0)
  for (int kb = wid; kb < 65; kb += 16) {
    bf16x8 kfa[4], kfb[4]; const bool two = kb + 8 < 65;
    LOADK(kfa, kb); if (two) LOADK(kfb, kb + 8);
    SCOREK(kfa, kb); if (two) SCOREK(kfb, kb + 8);
  }
#undef LOADK
#undef SCOREK
  __syncthreads();
#pragma unroll
  for (int rr = 0; rr < 2; ++rr) { const int q = 2 * wid + rr;
#pragma unroll
    for (int mp = 0; mp < (BR == 0 ? 2 : 1); ++mp) { float* S = (mp == 0 ? S1 : S2) + q * SST;
      float mx = -1e30f; for (int j = lane; j < PAST + 16; j += 64) mx = fmaxf(mx, S[j]);
      mx = wave_max(mx);
      float sm = 0.f; for (int j = lane; j < PAST + 16; j += 64) { const float e = __builtin_amdgcn_exp2f(S[j] - mx); S[j] = e; sm += e; }
      sm = wave_sum(sm); const float inv = 1.f / sm;
      for (int j = lane; j < PAST + 16; j += 64) S[j] *= inv; }
    if (BR == 0) { float* A = S1 + q * SST; const float* Bm = S2 + q * SST; for (int j = lane; j < PAST + 16; j += 64) A[j] -= lam * Bm[j]; }
  }
  __syncthreads();
  { const int hf = lane >> 5, l31 = lane & 31;
    f32x4 acc[16];
#pragma unroll
    for (int q = 0; q < 16; ++q) acc[q] = (f32x4){0.f, 0.f, 0.f, 0.f};
#pragma unroll 1
    for (int k5 = 0; k5 < 5; ++k5) { const int keyb = 130 * wid + 26 * k5 + hf;
      f32x4 v[13];
#pragma unroll
      for (int e = 0; e < 13; ++e) { const int key = keyb + 2 * e;
        if (key < PAST) v[e] = *(const f32x4*)(Vc + (size_t)key * 1024 + 4 * l31);
        else { const u32x2 w = *(const u32x2*)(Vn + (size_t)(key - PAST) * 1024 + 4 * l31); v[e] = (f32x4){bflo(w.x), bfhi(w.x), bflo(w.y), bfhi(w.y)}; } }
#pragma unroll
      for (int e = 0; e < 13; ++e) { const float* sp = S1 + keyb + 2 * e;
#pragma unroll
        for (int q = 0; q < 16; ++q) acc[q] += sp[q * SST] * v[e];
        asm volatile("" ::: "memory"); }
    }
#pragma unroll
    for (int q = 0; q < 16; ++q) {
#pragma unroll
      for (int i = 0; i < 4; ++i) acc[q][i] += __shfl_xor(acc[q][i], 32); }
    __syncthreads();
    if (hf == 0) {
#pragma unroll
      for (int q = 0; q < 16; ++q) *(f32x4*)(red + (wid * 16 + q) * 128 + 4 * l31) = acc[q]; }
  }
  __syncthreads();
  { const int q = tid >> 5, d4 = (tid & 31) * 4; f32x4 o = {0.f, 0.f, 0.f, 0.f};
#pragma unroll
    for (int w = 0; w < 8; ++w) o += *(const f32x4*)(red + (w * 16 + q) * 128 + d4);
    if (BR == 0) { float ss = o[0] * o[0] + o[1] * o[1] + o[2] * o[2] + o[3] * o[3];
#pragma unroll
      for (int s = 1; s < 32; s <<= 1) ss += __shfl_xor(ss, s);
      const float rs = rsqrtf(ss * (1.f / 128.f) + EPS) * (1.f - LAM_INIT); const f32x4 sl = *(const f32x4*)(P.subln + d4); o = o * sl * rs; }
    u32x2 w; w.x = cvt_pk_bf16(o[0], o[1]); w.y = cvt_pk_bf16(o[2], o[3]);
    *(u32x2*)(P.att + (qrow + q) * 2048 + (BR == 0 ? 0 : 1024) + h * 128 + d4) = w; }
}
}

__device__ __forceinline__ int src_col(int mode, int n) {
  if (mode == 0) return n;
  if (mode == 1) return n < 6144 ? n : (n < 10240 ? n + 8 : (n < 10248 ? n - 10240 + 6144 : -1));
  const int pn = n >> 8, j = n & 255; return j < 128 ? pn * 128 + j : DFF + pn * 128 + (j - 128);
}
__device__ __forceinline__ void transpose_item(const float* W, int Nsrc, int mode, bf16_t* WT, int ldwt, int koff, int nblk, LAS float* scr, int item, int lane) {
  const int kb = item / nblk, nb = item % nblk, k0 = 64 * kb, n0 = 32 * nb;
  const int sc = src_col(mode, n0 + (lane & 31));
  float tv[32]; const float* wp = W + (size_t)(k0 + (lane >> 5)) * Nsrc + (sc >= 0 ? sc : 0);
#pragma unroll
  for (int i = 0; i < 32; ++i) tv[i] = __builtin_nontemporal_load(wp + (size_t)(2 * i) * Nsrc);
#pragma unroll
  for (int i = 0; i < 32; ++i) scr[(2 * i + (lane >> 5)) * 33 + (lane & 31)] = sc >= 0 ? tv[i] : 0.f;
  asm volatile("s_waitcnt lgkmcnt(0)" ::: "memory");
  const int c = lane & 7;
#pragma unroll
  for (int j = 0; j < 4; ++j) { const int n = (lane >> 3) + 8 * j; const LAS float* s = scr + (8 * c) * 33 + n;
    u32x4 o; o.x = cvt_pk_bf16(s[0 * 33], s[1 * 33]); o.y = cvt_pk_bf16(s[2 * 33], s[3 * 33]); o.z = cvt_pk_bf16(s[4 * 33], s[5 * 33]); o.w = cvt_pk_bf16(s[6 * 33], s[7 * 33]);
    *(u32x4*)(WT + (size_t)(n0 + n) * ldwt + koff + k0 + 8 * c) = o; }
  asm volatile("s_waitcnt lgkmcnt(0)" ::: "memory");
}

#define XB_TMO      128
#define XB_XCNT(j)  (256  + 64 * (j))
#define XB_XSUB(j)  (1280 + 64 * (j))
#define XB_XGEN(j)  (2304 + 64 * (j))
#define XB_TOP      3328
#define XB_TOPGEN   3392
#define XCD_BAR_WORDS 3456
#define XB_SPIN_CAP (1u << 18)

__device__ __forceinline__ unsigned xb_ld(unsigned* p)              { return __hip_atomic_load(p, __ATOMIC_RELAXED, __HIP_MEMORY_SCOPE_AGENT); }
__device__ __forceinline__ unsigned xb_add(unsigned* p, unsigned v) { return __hip_atomic_fetch_add(p, v, __ATOMIC_RELAXED, __HIP_MEMORY_SCOPE_AGENT); }
__device__ __forceinline__ unsigned xb_xcc_id() { return (unsigned)__builtin_amdgcn_s_getreg((3 << 11) | 20) & 0xFu; }
#define XB_SPIN(cond, bar) do { unsigned _sp = 0; while (cond) { __builtin_amdgcn_s_sleep(1); \
    if ((++_sp & 255u) == 0u) { if (xb_ld(&(bar)[XB_TMO])) break; if (_sp > XB_SPIN_CAP) { atomicAdd(&(bar)[XB_TMO], 1u); break; } } } } while (0)

struct XcdBarrier {
    unsigned* bar; unsigned x;
    volatile LAS unsigned* st;
};

__device__ __forceinline__ XcdBarrier xcd_barrier_post(unsigned* bar, volatile LAS unsigned* st) {
    XcdBarrier b; b.bar = bar; b.x = xb_xcc_id(); b.st = st;
    if (threadIdx.x == 0) (void)xb_add(&bar[XB_XCNT(b.x)], 1u);
    return b;
}
__device__ __forceinline__ void xcd_barrier_complete(unsigned* bar, unsigned x, unsigned& nloc, unsigned& nx) {
    const unsigned G = gridDim.x * gridDim.y * gridDim.z;
    unsigned sum, cnt, mine, sp = 0u;
    for (;;) {
        sum = 0u; cnt = 0u; mine = 0u;
#pragma unroll
        for (unsigned j = 0; j < 16; ++j) { const unsigned c = xb_ld(&bar[XB_XCNT(j)]); sum += c; cnt += (c > 0u) ? 1u : 0u; mine = (j == x) ? c : mine; }
        if (sum == G) break;
        __builtin_amdgcn_s_sleep(1);
        if ((++sp & 255u) == 0u) { if (xb_ld(&bar[XB_TMO])) break; if (sp > XB_SPIN_CAP) { atomicAdd(&bar[XB_TMO], 1u); break; } }
    }
    nloc = mine > 0u ? mine : 1u; nx = cnt > 0u ? cnt : 1u;
}

__device__ __forceinline__ void xcd_barrier(const XcdBarrier& b) {
    asm volatile("s_waitcnt vmcnt(0)" ::: "memory");
    __syncthreads();
    if (threadIdx.x == 0) {
        unsigned* bar = b.bar;
        __builtin_amdgcn_s_waitcnt(0);
        unsigned nloc = b.st[0], nx = b.st[1];
        if (nloc == 0u) { xcd_barrier_complete(bar, b.x, nloc, nx); b.st[0] = nloc; b.st[1] = nx; }
        const unsigned old = xb_add(&bar[XB_XSUB(b.x)], 1u);
        const unsigned gen = old / nloc;
        if (old + 1u == (gen + 1u) * nloc) {
            __builtin_amdgcn_fence(__ATOMIC_RELEASE, "agent");
            asm volatile("s_waitcnt vmcnt(0)" ::: "memory");
            const unsigned og = xb_add(&bar[XB_TOP], 1u);
            const unsigned tg = og / nx;
            if (og + 1u == (tg + 1u) * nx) xb_add(&bar[XB_TOPGEN], 1u);
            else XB_SPIN(xb_ld(&bar[XB_TOPGEN]) == tg, bar);
            __builtin_amdgcn_fence(__ATOMIC_ACQUIRE, "agent");
            xb_add(&bar[XB_XGEN(b.x)], 1u);
            asm volatile("s_waitcnt vmcnt(0)" ::: "memory");
        } else {
            XB_SPIN(xb_ld(&bar[XB_XGEN(b.x)]) == gen, bar);
            __builtin_amdgcn_fence(__ATOMIC_ACQUIRE, "agent");
            asm volatile("s_waitcnt vmcnt(0)" ::: "memory");
        }
    }
    __syncthreads();
}

__device__ __forceinline__ void transpose_item64(const float* W, int Nsrc, int mode, bf16_t* WT, int ldwt, int koff, int nblk, LAS float* scr, int item, int lane) {
  const int kb = item / nblk, nb = item % nblk, k0 = 64 * kb, n0 = 64 * nb;
  const int kr = lane >> 4, nq = (lane & 15) * 4;
  const int sc = src_col(mode, n0 + nq);
  const float* wp = W + (size_t)(k0 + kr) * Nsrc + (sc >= 0 ? sc : 0);
  f32x4 tv[16];
#pragma unroll
  for (int i = 0; i < 16; ++i) tv[i] = __builtin_nontemporal_load((const f32x4*)(wp + (size_t)(4 * i) * Nsrc));
#pragma unroll
  for (int i = 0; i < 16; ++i) { LAS float* d = scr + (4 * i + kr) * 65 + nq; const f32x4 v = sc >= 0 ? tv[i] : (f32x4){0.f, 0.f, 0.f, 0.f}; d[0] = v.x; d[1] = v.y; d[2] = v.z; d[3] = v.w; }
  asm volatile("s_waitcnt lgkmcnt(0)" ::: "memory");
  const int c = lane & 7, nl = lane >> 3;
#pragma unroll
  for (int j = 0; j < 8; ++j) { const int n = nl + 8 * j; const LAS float* s = scr + (8 * c) * 65 + n;
    u32x4 o; o.x = cvt_pk_bf16(s[0 * 65], s[1 * 65]); o.y = cvt_pk_bf16(s[2 * 65], s[3 * 65]); o.z = cvt_pk_bf16(s[4 * 65], s[5 * 65]); o.w = cvt_pk_bf16(s[6 * 65], s[7 * 65]);
    *(u32x4*)(WT + (size_t)(n0 + n) * ldwt + koff + k0 + 8 * c) = o; }
  asm volatile("s_waitcnt lgkmcnt(0)" ::: "memory");
}

struct Args { const float* in[27]; float* out; unsigned char* ws; int ph_lo, ph_hi; };

__global__ void __launch_bounds__(512, 2) mega_fwd(Args a) {
  extern __shared__ __attribute__((aligned(16))) unsigned char lds[];
  cg::grid_group grid = cg::this_grid();
  const int tid = threadIdx.x, lane = tid & 63, wave = __builtin_amdgcn_readfirstlane(tid >> 6);
  const int G = gridDim.x, bx = blockIdx.x;
  const int gw = bx * 8 + wave, NGW = G * 8;
  unsigned char* ws = a.ws; float* out = a.out;
  const float* x_p = a.in[0]; const float* x_s = a.in[1];
  bf16_t* WT_IN = (bf16_t*)(ws + WS_WT_IN); bf16_t* WT_MRG = (bf16_t*)(ws + WS_WT_MRG); bf16_t* WT_OUT = (bf16_t*)(ws + WS_WT_OUT);
  bf16_t* WT_UP = (bf16_t*)(ws + WS_WT_UP); bf16_t* WT_DN = (bf16_t*)(ws + WS_WT_DN); bf16_t* XN = (bf16_t*)(ws + WS_XN);
  bf16_t* QKV = (bf16_t*)(ws + WS_QKV); bf16_t* GATES = (bf16_t*)(ws + WS_GATES); float* LOGF = (float*)(ws + WS_LOGF);
  bf16_t* ATT = (bf16_t*)(ws + WS_ATT); bf16_t* T1 = (bf16_t*)(ws + WS_T1); bf16_t* GB = (bf16_t*)(ws + WS_G); bf16_t* MO = (bf16_t*)(ws + WS_MO);
  bf16_t* HH = (bf16_t*)(ws + WS_HH); float* TAIL = (float*)(ws + WS_TAIL); float* HEAD = (float*)(ws + WS_HEAD); float* PART = (float*)(ws + WS_ATT); float* NRM = (float*)(ws + WS_LOGF + 768 * 1024);
  PG8_LAS unsigned char* ldsl = (PG8_LAS unsigned char*)lds;
  const int lo = a.ph_lo, hi = a.ph_hi;
  volatile LAS unsigned* MISC = (volatile LAS unsigned*)((LAS unsigned char*)lds + MISC_OFF);
  if (tid < 32) MISC[tid] = 0u;
  __syncthreads();
  const XcdBarrier bar = xcd_barrier_post((unsigned*)(ws + WS_BAR), MISC + 8);
#ifndef PHMASK
#define PHMASK 0x3ff
#endif
#define IN(k) (((PHMASK >> (k)) & 1) && lo <= (k) && (k) < hi)
#ifndef DUPPH
#define DUPPH -1
#endif
#ifndef DUPATT
#define DUPATT 0
#endif
#define ATTREP(m) (((DUPATT) & (m)) ? 2 : 1)
#define REPS(k) ((DUPPH) == (k) ? 2 : 1)
#define SEAM(k) do { if (IN(k) && IN((k) + 1)) { if (lo < 0) grid.sync(); else xcd_barrier(bar); } } while (0)

  if (IN(0)) _Pragma("nounroll") for (int rep_ = 0; rep_ < REPS(0); ++rep_) {
    LAS float* scr = (LAS float*)(ldsl + wave * 16896);
    constexpr int I_IN = 32 * 164;
    for (int it = gw; it < I_IN; it += NGW) transpose_item64(a.in[10], NIN, 1, WT_IN, 2048, 0, 164, scr, it, lane);
    if (bx == 0 && tid < 128) NRM[tid] = 0.f;
    const float* gain = a.in[9];
    for (int m0 = gw; m0 < MT; m0 += 2 * NGW) {
      const int m1 = (m0 + NGW < MT) ? m0 + NGW : m0;
      const float* xr0 = m0 < MP ? x_p + (size_t)m0 * DM : x_s + (size_t)(m0 - MP) * DM;
      const float* xr1 = m1 < MP ? x_p + (size_t)m1 * DM : x_s + (size_t)(m1 - MP) * DM;
      f32x4 va[8], vb[8]; float sa = 0.f, sb = 0.f;
#pragma unroll
      for (int j = 0; j < 8; ++j) { va[j] = *(const f32x4*)(xr0 + 4 * (64 * j + lane)); vb[j] = *(const f32x4*)(xr1 + 4 * (64 * j + lane)); }
#pragma unroll
      for (int j = 0; j < 8; ++j) { sa += (va[j].x * va[j].x + va[j].y * va[j].y) + (va[j].z * va[j].z + va[j].w * va[j].w); sb += (vb[j].x * vb[j].x + vb[j].y * vb[j].y) + (vb[j].z * vb[j].z + vb[j].w * vb[j].w); }
      const float ra = rsqrtf(wave_sum(sa) * (1.f / DM) + EPS), rb = rsqrtf(wave_sum(sb) * (1.f / DM) + EPS);
#pragma unroll
      for (int j = 0; j < 8; ++j) { const f32x4 gn = *(const f32x4*)(gain + 4 * (64 * j + lane)); const f32x4 ya = va[j] * ra * gn, yb = vb[j] * rb * gn;
        u32x2 w; w.x = cvt_pk_bf16(ya.x, ya.y); w.y = cvt_pk_bf16(ya.z, ya.w); *(u32x2*)(XN + (size_t)m0 * DM + 4 * (64 * j + lane)) = w;
        if (m1 != m0) { u32x2 w2; w2.x = cvt_pk_bf16(yb.x, yb.y); w2.y = cvt_pk_bf16(yb.z, yb.w); *(u32x2*)(XN + (size_t)m1 * DM + 4 * (64 * j + lane)) = w2; } }
    }
  }
  SEAM(0);
  if (IN(1)) _Pragma("nounroll") for (int rep_ = 0; rep_ < REPS(1); ++rep_) {
    pg8::Gemm g{XN, WT_IN, 2048, 2048, MT, NIN_PAD, 2048}; pg8::StaticOrder S; S.init(MT, NIN_PAD, G, bx, 2048);
    pg8::EpiIn E{QKV, GATES, LOGF, out, a.in[11], NRM, (PG8_LAS float*)(ldsl + STG_OFF)};
    pg8::gemm_phase<pg8::EpiIn, pg8::StaticOrder, true, true>(ldsl, g, S, E);
  }
  SEAM(1);
  if (IN(2)) {
    float lam;
    { const float d1 = wave_sum(a.in[12][lane] * a.in[13][lane]), d2 = wave_sum(a.in[14][lane] * a.in[15][lane]); lam = expf(d1) - expf(d2) + LAM_INIT; }
    const att::AttnP P{QKV, LOGF, ATT, a.in[8], a.in[16]};
    const int vcu = (G % 8 == 0) ? (bx & 7) * (G >> 3) + (bx >> 3) : bx;
#define CONVERT_REST() do { LAS float* scr = (LAS float*)(ldsl + wave * 16896); __syncthreads(); \
      constexpr int I_BD = 16 * 32, I_OUT = 32 * 32, I_UP = 32 * 256, I_DN = 128 * 32, NIT = 2 * I_BD + I_OUT + I_UP + I_DN; \
      for (int it = gw; it < NIT; it += NGW) { int r = it; \
        if (r < I_BD) { transpose_item64(a.in[17], 2048, 0, WT_MRG, 2048, 0, 32, scr, r, lane); continue; } r -= I_BD; \
        if (r < I_BD) { transpose_item64(a.in[18], 2048, 0, WT_MRG, 2048, 1024, 32, scr, r, lane); continue; } r -= I_BD; \
        if (r < I_OUT) { transpose_item64(a.in[19], 2048, 0, WT_OUT, 2048, 0, 32, scr, r, lane); continue; } r -= I_OUT; \
        if (r < I_UP) { transpose_item64(a.in[22], 16384, 2, WT_UP, 2048, 0, 256, scr, r, lane); continue; } r -= I_UP; \
        transpose_item64(a.in[25], 2048, 0, WT_DN, 8192, 0, 32, scr, r, lane); } \
      __syncthreads(); } while (0)
    if ((bx & 1) == 0) CONVERT_REST();
#ifndef ATTSUB
#define ATTSUB 7
#endif
    if (ATTSUB & 1) for (int pi_ = vcu; pi_ < 512 * ATTREP(1); pi_ += G) { const int pi = pi_ & 511; const int bh = pi >> 5, s = pi & 31, b = bh >> 3, h = bh & 7;
      att::diff_setup(a.in[8], h, (char*)lds);
      att::attn_unit<0>(P, b, h, s, 0, (char*)lds, lam);
      att::attn_unit<0>(P, b, h, 63 - s, 0, (char*)lds, lam); }
    if (ATTSUB & 2) for (int pi_ = vcu; pi_ < 256 * ATTREP(2); pi_ += G) { const int pi = pi_ & 255; const int bh = pi >> 4, s = pi & 15, b = bh >> 3, h = bh & 7;
      { const int j0 = att::fox_setup(LOGF, NRM, b, h, 256 * s, (char*)lds); att::attn_unit<1>(P, b, h, s, j0, (char*)lds, lam); }
      { const int j0 = att::fox_setup(LOGF, NRM, b, h, 256 * (31 - s), (char*)lds); att::attn_unit<1>(P, b, h, 31 - s, j0, (char*)lds, lam); } }
    const smp::SampP SP{QKV, LOGF, {a.in[2], a.in[4]}, {a.in[3], a.in[5]}, a.in[6], ATT, a.in[8], a.in[16]};
    if (ATTSUB & 4) for (int ui_ = bx; ui_ < 512 * ATTREP(4); ui_ += G) { const int ui = ui_ & 511; const int br = ui >> 8, bsh = ui & 255, bs = bsh >> 3, h = bsh & 7;
      if (br == 0) smp::sample_unit<0>(SP, bs, h, (char*)lds, lam); else smp::sample_unit<1>(SP, bs, h, (char*)lds, lam); }
    __syncthreads();
    if (bx & 1) CONVERT_REST();
#undef CONVERT_REST
  }
  SEAM(2);
  if (IN(3)) _Pragma("nounroll") for (int rep_ = 0; rep_ < REPS(3); ++rep_) {
    pg8::StaticOrder S; S.init(MT, 2048, G, bx, 1024);
    { pg8::Gemm g{ATT, WT_MRG, 2048, 2048, MT, 2048, 1024}; pg8::EpiMerge<0> E{GATES, T1, GB};
      pg8::gemm_phase<pg8::EpiMerge<0>, pg8::StaticOrder, true, true>(ldsl, g, S, E); }
    { pg8::Gemm g{ATT + 1024, WT_MRG + 1024, 2048, 2048, MT, 2048, 1024}; pg8::EpiMerge<1> E{GATES, T1, GB};
      pg8::gemm_phase<pg8::EpiMerge<1>, pg8::StaticOrder, true, true>(ldsl, g, S, E); }
  }
  SEAM(3);
  if (IN(4)) _Pragma("nounroll") for (int rep_ = 0; rep_ < REPS(4); ++rep_) {
    pg8::Gemm g{GB, WT_OUT, 2048, 2048, MT, 2048, 2048}; pg8::SplitOrder S; S.init(G, bx, 2048);
    pg8::EpiPlain E{MO, 2048, PART};
    pg8::gemm_phase<pg8::EpiPlain, pg8::SplitOrder, true, true>(ldsl, g, S, E);
  }
  SEAM(4);
  if (IN(5)) _Pragma("nounroll") for (int rep_ = 0; rep_ < REPS(5); ++rep_) {
    const float* g1 = a.in[20]; const float* g2 = a.in[21];
    for (int m = gw; m < MT; m += NGW) {
      const float* xrow = m < MP ? x_p + (size_t)m * DM : x_s + (size_t)(m - MP) * DM;
      f32x4 xin[8];
#pragma unroll
      for (int j = 0; j < 8; ++j) xin[j] = *(const f32x4*)(xrow + 4 * (64 * j + lane));
      f32x4 v[8]; float ss = 0.f;
#pragma unroll
      for (int j = 0; j < 8; ++j) {
        if (m < MP) { const u32x2 w = *(const u32x2*)(MO + (size_t)m * DM + 4 * (64 * j + lane)); v[j] = (f32x4){bflo(w.x), bfhi(w.x), bflo(w.y), bfhi(w.y)}; }
        else { v[j] = (f32x4){0.f, 0.f, 0.f, 0.f};
#pragma unroll
          for (int ks = 0; ks < 16; ++ks) v[j] += *(const f32x4*)(PART + ((size_t)ks * MSAMP + (m - MP)) * DM + 4 * (64 * j + lane)); }
        ss += (v[j].x * v[j].x + v[j].y * v[j].y) + (v[j].z * v[j].z + v[j].w * v[j].w); }
      const float r = rsqrtf(wave_sum(ss) * (1.f / DM) + EPS); float ss2 = 0.f;
#pragma unroll
      for (int j = 0; j < 8; ++j) { const f32x4 gn = *(const f32x4*)(g1 + 4 * (64 * j + lane)); const f32x4 xv = xin[j];
        v[j] = xv + v[j] * r * gn; *(f32x4*)(out + O_Y + (size_t)m * DM + 4 * (64 * j + lane)) = v[j];
        ss2 += (v[j].x * v[j].x + v[j].y * v[j].y) + (v[j].z * v[j].z + v[j].w * v[j].w); }
      const float r2 = rsqrtf(wave_sum(ss2) * (1.f / DM) + EPS);
#pragma unroll
      for (int j = 0; j < 8; ++j) { const f32x4 gn = *(const f32x4*)(g2 + 4 * (64 * j + lane)); const f32x4 y = v[j] * r2 * gn;
        u32x2 w; w.x = cvt_pk_bf16(y.x, y.y); w.y = cvt_pk_bf16(y.z, y.w); *(u32x2*)(XN + (size_t)m * DM + 4 * (64 * j + lane)) = w; }
    }
  }
  SEAM(5);
  if (IN(6)) _Pragma("nounroll") for (int rep_ = 0; rep_ < REPS(6); ++rep_) {
    pg8::Gemm g{XN, WT_UP, 2048, 2048, MT, 16384, 2048}; pg8::StaticOrder S; S.init(MT, 16384, G, bx, 2048);
    pg8::EpiUp E{HH, TAIL, HEAD, a.in[23], a.in[24], a.in[7], out, (PG8_LAS float*)(ldsl + XBUF_OFF)};
    pg8::gemm_phase<pg8::EpiUp, pg8::StaticOrder, true, true>(ldsl, g, S, E);
  }
  SEAM(6);
  if (IN(7)) {
    const float* cw = a.in[23]; const float* cb = a.in[24];
    for (int i = bx * 512 + tid; i < 64 * DFF; i += G * 512) { const int pm = i >> 13, c = i & (DFF - 1);
      const float* hp = HEAD + (size_t)pm * 4 * DFF + c; const float a0 = hp[0], b0 = hp[DFF], a1 = hp[2 * DFF], b1 = hp[3 * DFF];
      float t0 = 0.f, t1 = 0.f; if (pm & 31) { t0 = TAIL[((size_t)(pm - 1) * 2) * DFF + c]; t1 = TAIL[((size_t)(pm - 1) * 2 + 1) * DFF + c]; }
      const float w0 = cw[c], w1 = cw[DFF + c], w2 = cw[2 * DFF + c], bb = cb[c];
      const float ac0 = w0 * t0 + w1 * t1 + w2 * a0 + bb, ac1 = w0 * t1 + w1 * a0 + w2 * a1 + bb;
      HH[(size_t)(pm * 256) * DFF + c] = (bf16_t)(cvt_pk_bf16(gelu_tanh(ac0) * b0, 0.f) & 0xffffu);
      HH[(size_t)(pm * 256 + 1) * DFF + c] = (bf16_t)(cvt_pk_bf16(gelu_tanh(ac1) * b1, 0.f) & 0xffffu); }
  }
  SEAM(7);
  if (IN(8)) _Pragma("nounroll") for (int rep_ = 0; rep_ < REPS(8); ++rep_) {
    pg8::Gemm g{HH, WT_DN, 8192, 8192, MT, 2048, 8192}; pg8::SplitOrder S; S.init(G, bx, 8192);
    pg8::EpiPlain E{MO, 2048, PART};
    pg8::gemm_phase<pg8::EpiPlain, pg8::SplitOrder, true, true>(ldsl, g, S, E);
  }
  SEAM(8);
  if (IN(9)) {
    const float* g2 = a.in[26];
    for (int m = gw; m < MT; m += NGW) {
      f32x4 hin[8];
#pragma unroll
      for (int j = 0; j < 8; ++j) hin[j] = *(const f32x4*)(out + O_Y + (size_t)m * DM + 4 * (64 * j + lane));
      f32x4 v[8]; float ss = 0.f;
#pragma unroll
      for (int j = 0; j < 8; ++j) {
        if (m < MP) { const u32x2 w = *(const u32x2*)(MO + (size_t)m * DM + 4 * (64 * j + lane)); v[j] = (f32x4){bflo(w.x), bfhi(w.x), bflo(w.y), bfhi(w.y)}; }
        else { v[j] = (f32x4){0.f, 0.f, 0.f, 0.f};
#pragma unroll
          for (int ks = 0; ks < 16; ++ks) v[j] += *(const f32x4*)(PART + ((size_t)ks * MSAMP + (m - MP)) * DM + 4 * (64 * j + lane)); }
        ss += (v[j].x * v[j].x + v[j].y * v[j].y) + (v[j].z * v[j].z + v[j].w * v[j].w); }
      const float r = rsqrtf(wave_sum(ss) * (1.f / DM) + EPS);
#pragma unroll
      for (int j = 0; j < 8; ++j) { const f32x4 gn = *(const f32x4*)(g2 + 4 * (64 * j + lane)); float* yp = out + O_Y + (size_t)m * DM + 4 * (64 * j + lane);
        *(f32x4*)yp = hin[j] + v[j] * r * gn; }
    }
  }
#undef IN
#undef SEAM
}

extern "C" void kernel_launch(void* const* d_in, const int* in_sizes, int n_in, void* d_out, int out_size, void* d_ws, size_t ws_size, hipStream_t stream) {
  static int grid = 0;
  if (grid == 0) {
    if (n_in != 27 || in_sizes[0] != MP * DM || (size_t)out_size != O_END || ws_size < WS_END) {
      fprintf(stderr, "kernel_launch: unexpected shapes: n_in %d in0 %d out %d ws %zu (need %zu)\n", n_in, n_in > 0 ? in_sizes[0] : -1, out_size, ws_size, (size_t)WS_END); grid = -1; return; }
    int dev = 0, cus = 0, per_cu = 0;
    hipGetDevice(&dev); hipDeviceGetAttribute(&cus, hipDeviceAttributeMultiprocessorCount, dev);
    if (hipFuncSetAttribute((const void*)mega_fwd, hipFuncAttributeMaxDynamicSharedMemorySize, LDS_BYTES) != hipSuccess) { fprintf(stderr, "kernel_launch: hipFuncSetAttribute failed\n"); grid = -1; return; }
    if (hipOccupancyMaxActiveBlocksPerMultiprocessor(&per_cu, (const void*)mega_fwd, 512, LDS_BYTES) != hipSuccess || per_cu < 1) { fprintf(stderr, "kernel_launch: occupancy query gave %d\n", per_cu); per_cu = 1; }
    (void)hipGetLastError();
    grid = cus * 1;
    fprintf(stderr, "kernel_launch: cus %d per_cu %d grid %d ws %zu\n", cus, per_cu, grid, ws_size);
  }
  if (grid < 0) return;
  if (hipMemsetAsync((char*)d_ws + WS_BAR, 0, BAR_BYTES, stream) != hipSuccess) { fprintf(stderr, "kernel_launch: memset of the barrier words failed\n"); return; }
  Args a{};
  for (int i = 0; i < 27; ++i) a.in[i] = (const float*)d_in[i];
  a.out = (float*)d_out; a.ws = (unsigned char*)d_ws; a.ph_lo = 0; a.ph_hi = 10;
  void* args[] = {&a};
  hipError_t e = hipLaunchCooperativeKernel((const void*)mega_fwd, dim3(grid), dim3(512), args, LDS_BYTES, stream);
  if (e != hipSuccess) fprintf(stderr, "kernel_launch: cooperative launch failed: %s (grid %d)\n", hipGetErrorString(e), grid);
}
```

```cpp
#include <hip/hip_runtime.h>
#include <hip/hip_bf16.h>
#include <hip/hip_cooperative_groups.h>
#include <cstdio>
#include <cstdint>
namespace cg = cooperative_groups;

constexpr int DM = 2048, SEQ = 8192, MP = 16384, MSAMP = 512, MT = 16896, PAST = 1024, DFF = 8192;
constexpr int NIN = 10248, NIN_PAD = 10496;
constexpr float EPS = 1e-6f, LOG2E = 1.4426950408889634f;
constexpr float SC_D = 0.125f * LOG2E, SC_F = 0.08838834764831845f * LOG2E;
constexpr float LAM_INIT = 0.2f;
constexpr size_t O_Y = 0, O_DKP = 34603008, O_DVP = 51380224, O_FKP = 68157440, O_FVP = 84934656, O_LFP = 101711872, O_CVP = 101842944,
                 O_DKS = 101875712, O_DVS = 102400000, O_FKS = 102924288, O_FVS = 103448576, O_LFS = 103972864, O_CVS = 103976960, O_END = 104501248;
constexpr size_t MiB = 1u << 20;
constexpr size_t WS_WT_IN = 0, WS_WT_MRG = 41 * MiB, WS_WT_OUT = 49 * MiB, WS_WT_UP = 57 * MiB, WS_WT_DN = 121 * MiB, WS_XN = 153 * MiB,
                 WS_QKV = 219 * MiB, WS_GATES = 417 * MiB, WS_LOGF = 549 * MiB, WS_ATT = 550 * MiB, WS_T1 = 616 * MiB, WS_G = 682 * MiB,
                 WS_MO = 748 * MiB, WS_HH = 219 * MiB, WS_TAIL = 814 * MiB, WS_HEAD = 819 * MiB, WS_END = 828 * MiB;
constexpr int LDS_BYTES = 155648;
constexpr int MISC_OFF = 155520;
constexpr size_t WS_BAR = 549 * MiB + 800 * 1024, BAR_BYTES = 16384;
constexpr int STG_OFF = 135168;
constexpr int XBUF_OFF = 131072;

#define LAS __attribute__((address_space(3)))
typedef unsigned short bf16_t;
typedef short bf16x8 __attribute__((ext_vector_type(8)));
typedef short s16x4 __attribute__((ext_vector_type(4)));
typedef float f32x4 __attribute__((ext_vector_type(4)));
typedef float f32x2 __attribute__((ext_vector_type(2)));
typedef float f32x16 __attribute__((ext_vector_type(16)));
typedef unsigned u32x4 __attribute__((ext_vector_type(4)));
typedef unsigned u32x2 __attribute__((ext_vector_type(2)));

__device__ __forceinline__ unsigned cvt_pk_bf16(float lo, float hi) { unsigned r; asm volatile("v_cvt_pk_bf16_f32 %0, %1, %2" : "=v"(r) : "v"(lo), "v"(hi)); return r; }
__device__ __forceinline__ float bf2f(unsigned short x) { return __uint_as_float((unsigned)x << 16); }
__device__ __forceinline__ float bflo(unsigned w) { return __uint_as_float(w << 16); }
__device__ __forceinline__ float bfhi(unsigned w) { return __uint_as_float(w & 0xffff0000u); }
__device__ __forceinline__ u32x4 pack8(const f32x4 a, const f32x4 b) { u32x4 w; w.x = cvt_pk_bf16(a[0], a[1]); w.y = cvt_pk_bf16(a[2], a[3]); w.z = cvt_pk_bf16(b[0], b[1]); w.w = cvt_pk_bf16(b[2], b[3]); return w; }
__device__ __forceinline__ void unpack8(const u32x4 w, f32x4& a, f32x4& b) { a = (f32x4){bflo(w.x), bfhi(w.x), bflo(w.y), bfhi(w.y)}; b = (f32x4){bflo(w.z), bfhi(w.z), bflo(w.w), bfhi(w.w)}; }
__device__ __forceinline__ float wave_sum(float v) {
#pragma unroll
    for (int o = 1; o < 64; o <<= 1) v += __shfl_xor(v, o);
    return v;
}
__device__ __forceinline__ float wave_max(float v) {
#pragma unroll
    for (int o = 1; o < 64; o <<= 1) v = fmaxf(v, __shfl_xor(v, o));
    return v;
}
__device__ __forceinline__ float gelu_tanh(float x) {
    const float u2 = 1.5957691216057308f * x * (1.0f + 0.044715f * x * x);
    return x * __builtin_amdgcn_rcpf(1.0f + __builtin_amdgcn_exp2f(-u2 * LOG2E));
}
__device__ __forceinline__ int t5_bucket(int rel) {
    const int n = rel < 0 ? -rel : rel; int v;
    if (n < 8) v = n; else { const int k = (31 - __clz(n * n)) - 6; v = 8 + k; if (v > 15) v = 15; }
    return (rel > 0 ? 16 : 0) + v;
}
template <int CTRL> __device__ __forceinline__ float dppf(float v) { return __builtin_bit_cast(float, __builtin_amdgcn_update_dpp(0, __builtin_bit_cast(int, v), CTRL, 0xf, 0xf, true)); }

namespace pg8 {
#define PG8_LAS __attribute__((address_space(3)))
constexpr int BM = 256, BK = 64, HALF = 128, HTB = HALF * BK * 2  , STAGE_BYTES = 8 * HTB, NXCD = 8, WGM = 8;

__host__ __device__ __forceinline__ int lds_byte(int r, int c) { const int st = (r >> 4) * 2 + (c >> 5), rr = r & 15, cc = c & 31, ob = rr * 64 + cc * 2; return st * 1024 + (ob ^ (((ob >> 9) & 1) << 5)); }
__host__ __device__ __forceinline__ void stage_rc(int b, int& R, int& C) { const int st = b / 1024, sb = b % 1024, swz = sb ^ (((sb >> 9) & 1) << 5); R = (st >> 1) * 16 + swz / 64; C = (st & 1) * 32 + (swz % 64) / 2; }
__host__ __device__ __forceinline__ int perm32(int rho) { const int n = rho >> 4, i = rho & 15; return 8 * (i >> 2) + 4 * n + (i & 3); }

struct Unit { int pm, pn, k0, nt, part; };
struct Gemm { const bf16_t* A; const bf16_t* Bt; int lda, ldb, M, N, K; };

struct StaticOrder {
    int nM, nN, nwg, G, c, ntk;
    __host__ __device__ void init(int M, int N, int G_, int c_, int K) { nM = M / BM; nN = N / BM; nwg = nM * nN; G = G_; c = c_; ntk = K / BK; }
    __host__ __device__ __forceinline__ bool next(int i, Unit& u) const {
        const long L = (long)i * G + c; const bool ok = L < nwg;
        int wgid = ok ? (int)L : nwg - 1; { const int q = nwg / NXCD, r = nwg % NXCD, xcd = wgid % NXCD, off = wgid / NXCD; wgid = (xcd < r ? xcd * (q + 1) : r * (q + 1) + (xcd - r) * q) + off; }
        const int nig = WGM * nN, gid = wgid / nig, fm = gid * WGM, gsz = (nM - fm) < WGM ? (nM - fm) : WGM;
        u.pm = fm + ((wgid % nig) % gsz); u.pn = (wgid % nig) / gsz; u.k0 = 0; u.nt = ntk; u.part = -1; return ok;
    }
    __device__ __forceinline__ void a_ready(const Unit&) const {}
    __device__ __forceinline__ void done(const Unit&) const {}
};

struct SplitOrder {
    StaticOrder P; int RP, K;
    __host__ __device__ void init(int G_, int c_, int K_) { P.init(MP, 2048, G_, c_, K_); RP = (P.nwg + G_ - 1) / G_; K = K_; }
    __host__ __device__ __forceinline__ bool next(int i, Unit& u) const {
        const int np = P.c < P.nwg ? (P.nwg - P.c + P.G - 1) / P.G : 0;
        const bool isP = i < np; Unit a; const bool okA = P.next(isP ? i : 0, a);
        const long idx = (long)(i - np) * P.G + P.c; const bool okB = !isP && idx < 256; const int ii = (int)idx & 255;
        u.pm = isP ? a.pm : 64 + (ii >> 7); u.pn = isP ? a.pn : (ii >> 4) & 7; u.k0 = isP ? 0 : (ii & 15) * (K / 16); u.nt = isP ? P.ntk : K / 16 / BK; u.part = isP ? -1 : (ii & 15);
        return isP ? okA : okB;
    }
    __device__ __forceinline__ void a_ready(const Unit&) const {}
    __device__ __forceinline__ void done(const Unit&) const {}
};


struct EpiIn {
    static constexpr bool PERM = true, AFTER_DRAIN = false;
    bf16_t* qkv; bf16_t* gates; float* logf_ws; float* out; const float* b_forget; float* nrm; PG8_LAS float* stg;
    __device__ __forceinline__ void operator()(const f32x4 (&acc)[2][2][4][2], const Unit& u, int wr, int wc, int fr, int fq) const {
        const int pn = u.pn; const int row0 = u.pm * BM + wr * 64 + fr; const bool samp = u.pm >= 64;
        if (pn < 24) {
            const int grp = pn >> 2; const float sc = grp == 0 ? SC_D : (grp == 3 ? SC_F : 1.f);
            bf16_t* base = qkv + (size_t)grp * MT * 1024; const int col0 = (pn & 3) * 256 + wc * 32 + 8 * fq;
            float* fo = nullptr;
            if (grp == 1) fo = out + (samp ? O_DKS : O_DKP); else if (grp == 2) fo = out + (samp ? O_DVS : O_DVP);
            else if (grp == 4) fo = out + (samp ? O_FKS : O_FKP); else if (grp == 5) fo = out + (samp ? O_FVS : O_FVP);
            PG8_LAS float* st = stg + (wr * 4 + wc) * 576; const int ln = fq * 16 + fr, srow = ln >> 2, sseg = ln & 3;
#pragma unroll
            for (int ai = 0; ai < 2; ++ai)
#pragma unroll
                for (int m = 0; m < 4; ++m) { const int row = row0 + ai * HALF + m * 16;
                    const int g0 = u.pm * BM + ai * HALF + wr * 64 + m * 16 - (samp ? MP : 0);
#pragma unroll
                    for (int bj = 0; bj < 2; ++bj) { const f32x4 v0 = acc[ai][bj][m][0] * sc, v1 = acc[ai][bj][m][1] * sc;
                        *(u32x4*)(base + (size_t)row * 1024 + col0 + bj * HALF) = pack8(v0, v1);
                        if (fo) {
                            *(PG8_LAS f32x4*)(st + fr * 36 + 8 * fq) = v0; *(PG8_LAS f32x4*)(st + fr * 36 + 8 * fq + 4) = v1;
                            asm volatile("s_waitcnt lgkmcnt(0)" ::: "memory");
                            const f32x4 sa = *(const PG8_LAS f32x4*)(st + srow * 36 + 4 * sseg), sb = *(const PG8_LAS f32x4*)(st + srow * 36 + 16 + 4 * sseg);
                            asm volatile("s_waitcnt lgkmcnt(0)" ::: "memory");
                            float* p = fo + (size_t)(g0 + srow) * 1024 + (pn & 3) * 256 + bj * HALF + wc * 32 + 4 * sseg; *(f32x4*)p = sa; *(f32x4*)(p + 16) = sb; } } }
            if ((grp == 3 || grp == 4) && !samp) {
                float mx[2] = {0.f, 0.f};
#pragma unroll
                for (int ai = 0; ai < 2; ++ai)
#pragma unroll
                    for (int m = 0; m < 4; ++m)
#pragma unroll
                        for (int bj = 0; bj < 2; ++bj) { const f32x4 v0 = acc[ai][bj][m][0] * sc, v1 = acc[ai][bj][m][1] * sc;
                            float s = (v0[0] * v0[0] + v0[1] * v0[1]) + (v0[2] * v0[2] + v0[3] * v0[3]) + (v1[0] * v1[0] + v1[1] * v1[1]) + (v1[2] * v1[2] + v1[3] * v1[3]);
                            s += __shfl_xor(s, 16); s += __shfl_xor(s, 32); mx[bj] = fmaxf(mx[bj], s); }
#pragma unroll
                for (int bj = 0; bj < 2; ++bj) {
#pragma unroll
                    for (int o = 1; o < 16; o <<= 1) mx[bj] = fmaxf(mx[bj], __shfl_xor(mx[bj], o));
                    if (fr == 0 && fq == 0) atomicMax((unsigned*)(nrm + (grp == 4 ? 64 : 0) + ((u.pm >> 5) * 8 + 2 * (pn & 3) + bj) * 4 + wc), __float_as_uint(mx[bj])); }
            }
        } else if (pn < 40) {
            const int col0 = (pn - 24) * 256 + wc * 32 + 8 * fq;
#pragma unroll
            for (int ai = 0; ai < 2; ++ai)
#pragma unroll
                for (int m = 0; m < 4; ++m) { const int row = row0 + ai * HALF + m * 16;
#pragma unroll
                    for (int bj = 0; bj < 2; ++bj) { f32x4 v0 = acc[ai][bj][m][0], v1 = acc[ai][bj][m][1];
#pragma unroll
                        for (int i = 0; i < 4; ++i) { v0[i] = __builtin_amdgcn_rcpf(1.f + __builtin_amdgcn_exp2f(-v0[i] * LOG2E)); v1[i] = __builtin_amdgcn_rcpf(1.f + __builtin_amdgcn_exp2f(-v1[i] * LOG2E)); }
                        *(u32x4*)(gates + (size_t)row * 4096 + col0 + bj * HALF) = pack8(v0, v1); } }
        } else {
            if (wc == 0 && fq == 0) {
                const f32x4 b0 = *(const f32x4*)b_forget, b1 = *(const f32x4*)(b_forget + 4);
#pragma unroll
                for (int ai = 0; ai < 2; ++ai)
#pragma unroll
                    for (int m = 0; m < 4; ++m) { const int row = row0 + ai * HALF + m * 16; const int rr = samp ? row - MP : row;
                        f32x4 v0 = acc[ai][0][m][0] + b0, v1 = acc[ai][0][m][1] + b1;
#pragma unroll
                        for (int i = 0; i < 4; ++i) { v0[i] = fminf(v0[i], 0.f) - log1pf(expf(-fabsf(v0[i]))); v1[i] = fminf(v1[i], 0.f) - log1pf(expf(-fabsf(v1[i]))); }
                        *(f32x4*)(logf_ws + (size_t)row * 8) = v0; *(f32x4*)(logf_ws + (size_t)row * 8 + 4) = v1;
                        float* p = out + (samp ? O_LFS : O_LFP) + (size_t)rr * 8; *(f32x4*)p = v0; *(f32x4*)(p + 4) = v1; }
            }
        }
    }
};

template <int STAGE> struct EpiMerge {
    static constexpr bool PERM = true, AFTER_DRAIN = false;
    const bf16_t* gates; bf16_t* t1; bf16_t* g;
    __device__ __forceinline__ void operator()(const f32x4 (&acc)[2][2][4][2], const Unit& u, int wr, int wc, int fr, int fq) const {
        const int row0 = u.pm * BM + wr * 64 + fr, col0 = u.pn * BM + wc * 32 + 8 * fq;
#pragma unroll
        for (int ai = 0; ai < 2; ++ai)
#pragma unroll
            for (int m = 0; m < 4; ++m) { const int row = row0 + ai * HALF + m * 16;
#pragma unroll
                for (int bj = 0; bj < 2; ++bj) { const int c = col0 + bj * HALF;
                    f32x4 g0, g1; unpack8(*(const u32x4*)(gates + (size_t)row * 4096 + STAGE * 2048 + c), g0, g1);
                    f32x4 v0 = acc[ai][bj][m][0] * g0, v1 = acc[ai][bj][m][1] * g1;
                    if (STAGE == 0) { *(u32x4*)(t1 + (size_t)row * 2048 + c) = pack8(v0, v1); }
                    else { f32x4 t0, t1v; unpack8(*(const u32x4*)(t1 + (size_t)row * 2048 + c), t0, t1v); *(u32x4*)(g + (size_t)row * 2048 + c) = pack8(v0 + t0, v1 + t1v); } } }
    }
};

struct EpiPlain {
    static constexpr bool PERM = true, AFTER_DRAIN = false;
    bf16_t* O; int ldc; float* part;
    __device__ __forceinline__ void operator()(const f32x4 (&acc)[2][2][4][2], const Unit& u, int wr, int wc, int fr, int fq) const {
        const int row0 = u.pm * BM + wr * 64 + fr, col0 = u.pn * BM + wc * 32 + 8 * fq;
        if (u.part < 0) {
#pragma unroll
            for (int ai = 0; ai < 2; ++ai)
#pragma unroll
                for (int m = 0; m < 4; ++m) { const int row = row0 + ai * HALF + m * 16;
#pragma unroll
                    for (int bj = 0; bj < 2; ++bj) *(u32x4*)(O + (size_t)row * ldc + col0 + bj * HALF) = pack8(acc[ai][bj][m][0], acc[ai][bj][m][1]); }
        } else {
            float* pb = part + (size_t)u.part * MSAMP * 2048;
#pragma unroll
            for (int ai = 0; ai < 2; ++ai)
#pragma unroll
                for (int m = 0; m < 4; ++m) { const int row = row0 + ai * HALF + m * 16 - MP;
#pragma unroll
                    for (int bj = 0; bj < 2; ++bj) { float* q = pb + (size_t)row * 2048 + col0 + bj * HALF; *(f32x4*)q = acc[ai][bj][m][0]; *(f32x4*)(q + 4) = acc[ai][bj][m][1]; } }
        }
    }
};

struct EpiUp {
    static constexpr bool PERM = true, AFTER_DRAIN = false;
    bf16_t* hh; float* tail; float* head; const float* conv_w; const float* conv_b; const float* state; float* out; PG8_LAS float* xbuf;
    __device__ __forceinline__ void operator()(const f32x4 (&acc)[2][2][4][2], const Unit& u, int wr, int wc, int fr, int fq) const {
        const int cl = wc * 32 + 8 * fq, cgc = u.pn * 128 + cl; const bool samp = u.pm >= 64;
        f32x4 cw0[2], cw1[2], cw2[2], cb[2];
#pragma unroll
        for (int n = 0; n < 2; ++n) { cw0[n] = *(const f32x4*)(conv_w + cgc + 4 * n); cw1[n] = *(const f32x4*)(conv_w + DFF + cgc + 4 * n); cw2[n] = *(const f32x4*)(conv_w + 2 * DFF + cgc + 4 * n); cb[n] = *(const f32x4*)(conv_b + cgc + 4 * n); }
        if (!samp) {
            if (fr >= 14) {
#pragma unroll
                for (int ai = 0; ai < 2; ++ai)
#pragma unroll
                    for (int n = 0; n < 2; ++n) *(PG8_LAS f32x4*)(xbuf + ((ai * 2 + wr) * 2 + (fr - 14)) * 128 + cl + 4 * n) = acc[ai][0][3][n];
            }
            asm volatile("s_waitcnt lgkmcnt(0)" ::: "memory"); __builtin_amdgcn_s_barrier(); asm volatile("" ::: "memory");
        }
#pragma unroll
        for (int ai = 0; ai < 2; ++ai) { const int blk = ai * 2 + wr;
#pragma unroll
            for (int m = 0; m < 4; ++m) {
                const int row = u.pm * BM + ai * HALF + wr * 64 + m * 16 + fr;
                f32x4 w1[2], w2[2];
                if (samp) {
                    const int bs = (row - MP) >> 4;
#pragma unroll
                    for (int n = 0; n < 2; ++n) { const f32x4 s0 = *(const f32x4*)(state + ((size_t)bs * 2 + 0) * DFF + cgc + 4 * n), s1 = *(const f32x4*)(state + ((size_t)bs * 2 + 1) * DFF + cgc + 4 * n);
                        w1[n] = s1; w2[n] = fr == 0 ? s0 : s1; }
                } else if (m == 0) {
                    if (blk > 0) {
#pragma unroll
                        for (int n = 0; n < 2; ++n) { const f32x4 c14 = *(const PG8_LAS f32x4*)(xbuf + ((blk - 1) * 2 + 0) * 128 + cl + 4 * n), c15 = *(const PG8_LAS f32x4*)(xbuf + ((blk - 1) * 2 + 1) * 128 + cl + 4 * n);
                            w1[n] = c15; w2[n] = fr == 0 ? c14 : c15; }
                    } else { w1[0] = w1[1] = w2[0] = w2[1] = (f32x4){0.f, 0.f, 0.f, 0.f}; }
                } else {
#pragma unroll
                    for (int n = 0; n < 2; ++n)
#pragma unroll
                        for (int i = 0; i < 4; ++i) { const float ap = acc[ai][0][m - 1][n][i]; w1[n][i] = dppf<0x10F>(ap); w2[n][i] = dppf<0x10E>(ap); }
                }
                f32x4 hv[2];
#pragma unroll
                for (int n = 0; n < 2; ++n) {
                    const f32x4 a = acc[ai][0][m][n], b = acc[ai][1][m][n];
#pragma unroll
                    for (int i = 0; i < 4; ++i) {
                        const float s1 = dppf<0x111>(a[i]), s2 = dppf<0x112>(a[i]);
                        const float p1 = fr >= 1 ? s1 : w1[n][i], p2 = fr >= 2 ? s2 : w2[n][i];
                        const float ac = cw0[n][i] * p2 + cw1[n][i] * p1 + cw2[n][i] * a[i] + cb[n][i];
                        hv[n][i] = gelu_tanh(ac) * b[i];
                    }
                }
                *(u32x4*)(hh + (size_t)row * DFF + cgc) = pack8(hv[0], hv[1]);
                if (samp) {
                    if (fr >= 14) { const int bs = (row - MP) >> 4; float* p = out + O_CVS + ((size_t)bs * 2 + (fr - 14)) * DFF + cgc; *(f32x4*)p = acc[ai][0][m][0]; *(f32x4*)(p + 4) = acc[ai][0][m][1]; }
                } else {
                    if (blk == 3 && m == 3 && fr >= 14) { float* p = tail + ((size_t)u.pm * 2 + (fr - 14)) * DFF + cgc; *(f32x4*)p = acc[ai][0][m][0]; *(f32x4*)(p + 4) = acc[ai][0][m][1];
                        if ((u.pm & 31) == 31) { float* q = out + O_CVP + ((size_t)(u.pm >> 5) * 2 + (fr - 14)) * DFF + cgc; *(f32x4*)q = acc[ai][0][m][0]; *(f32x4*)(q + 4) = acc[ai][0][m][1]; } }
                    if (blk == 0 && m == 0 && fr < 2) { float* p = head + (((size_t)u.pm * 2 + fr) * 2) * DFF + cgc; *(f32x4*)p = acc[ai][0][m][0]; *(f32x4*)(p + 4) = acc[ai][0][m][1];
                        *(f32x4*)(p + DFF) = acc[ai][1][m][0]; *(f32x4*)(p + DFF + 4) = acc[ai][1][m][1]; }
                }
            }
        }
    }
};

template <class Epi, class Sched, bool ALIGN_EPI = false, bool SP2 = false>
__device__ __forceinline__ void gemm_phase(PG8_LAS unsigned char* lds, const Gemm g, const Sched& S, const Epi& E) {
    const int tid = threadIdx.x, wid = __builtin_amdgcn_readfirstlane(tid >> 6), lane = tid & 63, wr = wid >> 2, wc = wid & 3, fr = lane & 15, fq = lane >> 4;
    const int K = g.K, nt = K / BK;
    unsigned voffA[2], voffB[2];
#pragma unroll
    for (int i = 0; i < 2; ++i) { int R, C; stage_rc(tid * 16 + i * 8192, R, C); const int Rb = Epi::PERM ? ((R & ~31) + perm32(R & 31)) : R;
        voffA[i] = (unsigned)(R * g.lda + C) * 2u; voffB[i] = (unsigned)(Rb * g.ldb + C) * 2u; }
    const size_t kstep = (size_t)(BK * 2);
    const size_t hstepA = (size_t)HALF * g.lda * 2, hstepB = (size_t)HALF * g.ldb * 2;
    const size_t tstepA = 2 * hstepA, tstepB = 2 * hstepB;
    const unsigned ldsw = (unsigned)wid * 1024u;
    const int aoff = lds_byte(wr * 64 + fr, fq * 8), boff = lds_byte(wc * 32 + fr, fq * 8);
#define PG8_SA(b, h) (((b) * 2 + (h)) * HTB)
#define PG8_SB(b, h) ((4 + (b) * 2 + (h)) * HTB)
#define PG8_STAGE(bufoff, gbase, voff) do { _Pragma("unroll") for (int _i = 0; _i < 2; ++_i) \
        __builtin_amdgcn_global_load_lds((const unsigned*)((const char*)(gbase) + (voff)[_i]), (PG8_LAS unsigned*)(lds + (bufoff) + ldsw + _i * 8192), 16, 0, 0); } while (0)
#define PG8_LDA(dst, b, h) do { _Pragma("unroll") for (int m = 0; m < 4; ++m) _Pragma("unroll") for (int k = 0; k < 2; ++k) dst[m][k] = *(const PG8_LAS bf16x8*)(lds + PG8_SA(b, h) + aoff + m * 2048 + k * 1024); } while (0)
#define PG8_LDB(dst, b, h) do { _Pragma("unroll") for (int n = 0; n < 2; ++n) _Pragma("unroll") for (int k = 0; k < 2; ++k) dst[n][k] = *(const PG8_LAS bf16x8*)(lds + PG8_SB(b, h) + boff + n * 2048 + k * 1024); } while (0)
#define PG8_MMA(ai, bj, At, Bt) do { __builtin_amdgcn_s_setprio(1); _Pragma("unroll") for (int m = 0; m < 4; ++m) _Pragma("unroll") for (int n = 0; n < 2; ++n) _Pragma("unroll") for (int k = 0; k < 2; ++k) \
        acc[ai][bj][m][n] = __builtin_amdgcn_mfma_f32_16x16x32_bf16(Bt[n][k], At[m][k], acc[ai][bj][m][n], 0, 0, 0); __builtin_amdgcn_s_setprio(0); } while (0)
#define PG8_WAIT_V(n) asm volatile("s_waitcnt vmcnt(" #n ")" ::: "memory")
#define PG8_WAIT_L(n) asm volatile("s_waitcnt lgkmcnt(" #n ")" ::: "memory")
#define PG8_BAR __builtin_amdgcn_s_barrier()
#define PG8_SCHED __builtin_amdgcn_sched_barrier(0)
    Unit cur, nxt; int ui = 0;
    if (!S.next(0, cur)) return;
    f32x4 acc[2][2][4][2];
#pragma unroll
    for (int a = 0; a < 2; ++a)
#pragma unroll
        for (int b = 0; b < 2; ++b)
#pragma unroll
            for (int m = 0; m < 4; ++m)
#pragma unroll
                for (int n = 0; n < 2; ++n) acc[a][b][m][n] = (f32x4){0.f, 0.f, 0.f, 0.f};
    bf16x8 At[4][2], B0[2][2], B1[2][2];
    const char* cA = (const char*)g.A + (size_t)cur.pm * tstepA + (size_t)cur.k0 * 2; const char* cB = (const char*)g.Bt + (size_t)cur.pn * tstepB + (size_t)cur.k0 * 2;
    S.a_ready(cur);
    if constexpr (SP2) {
        PG8_STAGE(PG8_SB(0, 0), cB, voffB); PG8_STAGE(PG8_SB(0, 1), cB + hstepB, voffB); PG8_STAGE(PG8_SA(0, 0), cA, voffA); PG8_STAGE(PG8_SA(0, 1), cA + hstepA, voffA);
        if (wr == 1) PG8_BAR;
        PG8_WAIT_V(2); PG8_BAR;
        PG8_STAGE(PG8_SB(1, 0), cB + kstep, voffB); PG8_STAGE(PG8_SA(1, 0), cA + kstep, voffA); PG8_STAGE(PG8_SB(1, 1), cB + hstepB + kstep, voffB);
        PG8_WAIT_V(6); PG8_BAR;
    } else {
        PG8_STAGE(PG8_SB(0, 0), cB, voffB); PG8_STAGE(PG8_SA(0, 0), cA, voffA); PG8_STAGE(PG8_SB(0, 1), cB + hstepB, voffB); PG8_STAGE(PG8_SA(0, 1), cA + hstepA, voffA);
        if (wr == 1) PG8_BAR;
        PG8_WAIT_V(4); PG8_BAR;
        PG8_STAGE(PG8_SB(1, 0), cB + kstep, voffB); PG8_STAGE(PG8_SA(1, 0), cA + kstep, voffA); PG8_STAGE(PG8_SB(1, 1), cB + hstepB + kstep, voffB);
        PG8_WAIT_V(6); PG8_BAR;
    }
    for (;;) {
        const bool has_next = S.next(ui + 1, nxt);
        const char* nA = has_next ? (const char*)g.A + (size_t)nxt.pm * tstepA + (size_t)nxt.k0 * 2 : cA; const char* nB = has_next ? (const char*)g.Bt + (size_t)nxt.pn * tstepB + (size_t)nxt.k0 * 2 : cB;
        const int ntc = cur.nt;
        for (int t = 0; t < ntc; t += 2) {
            const bool last = (t == ntc - 2);
            const char* a1 = cA + (size_t)(t + 1) * kstep;
            const char* a2 = last ? nA : cA + (size_t)(t + 2) * kstep; const char* b2 = last ? nB : cB + (size_t)(t + 2) * kstep;
            const char* a3 = a2 + kstep; const char* b3 = b2 + kstep;
            if (last && has_next) S.a_ready(nxt);
            if constexpr (SP2) {
            PG8_LDB(B0, 0, 0); PG8_LDB(B1, 0, 1); PG8_SCHED; PG8_LDA(At, 0, 0); PG8_STAGE(PG8_SA(1, 1), a1 + hstepA, voffA);
            PG8_WAIT_V(8); PG8_WAIT_L(0); PG8_BAR; PG8_MMA(0, 0, At, B0); PG8_MMA(0, 1, At, B1); PG8_BAR; PG8_SCHED;
            PG8_LDA(At, 0, 1); PG8_STAGE(PG8_SB(0, 0), b2, voffB); PG8_STAGE(PG8_SB(0, 1), b2 + hstepB, voffB); PG8_STAGE(PG8_SA(0, 0), a2, voffA);
            PG8_WAIT_V(8); PG8_WAIT_L(0); PG8_BAR; PG8_MMA(1, 0, At, B0); PG8_MMA(1, 1, At, B1); PG8_BAR; PG8_SCHED;
            PG8_LDB(B0, 1, 0); PG8_LDB(B1, 1, 1); PG8_SCHED; PG8_LDA(At, 1, 0); PG8_STAGE(PG8_SA(0, 1), a2 + hstepA, voffA);
            PG8_WAIT_V(8); PG8_WAIT_L(0); PG8_BAR; PG8_MMA(0, 0, At, B0); PG8_MMA(0, 1, At, B1); PG8_BAR; PG8_SCHED;
            PG8_LDA(At, 1, 1); PG8_STAGE(PG8_SB(1, 0), b3, voffB); PG8_STAGE(PG8_SB(1, 1), b3 + hstepB, voffB); PG8_STAGE(PG8_SA(1, 0), a3, voffA);
            PG8_WAIT_V(8); PG8_WAIT_L(0); PG8_BAR; PG8_MMA(1, 0, At, B0); PG8_MMA(1, 1, At, B1); PG8_BAR; PG8_SCHED;
            } else {
            PG8_LDB(B0, 0, 0); PG8_SCHED; PG8_LDA(At, 0, 0); PG8_STAGE(PG8_SA(1, 1), a1 + hstepA, voffA);
            PG8_WAIT_L(8); PG8_BAR; PG8_WAIT_L(0); PG8_MMA(0, 0, At, B0); PG8_BAR; PG8_SCHED;
            PG8_LDB(B1, 0, 1); PG8_STAGE(PG8_SB(0, 0), b2, voffB);
            PG8_BAR; PG8_WAIT_L(0); PG8_MMA(0, 1, At, B1); PG8_BAR;
            PG8_LDA(At, 0, 1); PG8_STAGE(PG8_SA(0, 0), a2, voffA);
            PG8_BAR; PG8_WAIT_L(0); PG8_MMA(1, 0, At, B0); PG8_BAR; PG8_SCHED;
            PG8_STAGE(PG8_SB(0, 1), b2 + hstepB, voffB);
            PG8_WAIT_V(6); PG8_BAR; PG8_MMA(1, 1, At, B1); PG8_BAR;
            PG8_LDB(B0, 1, 0); PG8_SCHED; PG8_LDA(At, 1, 0); PG8_STAGE(PG8_SA(0, 1), a2 + hstepA, voffA);
            PG8_WAIT_L(8); PG8_BAR; PG8_WAIT_L(0); PG8_MMA(0, 0, At, B0); PG8_BAR; PG8_SCHED;
            PG8_LDB(B1, 1, 1); PG8_STAGE(PG8_SB(1, 0), b3, voffB);
            PG8_BAR; PG8_WAIT_L(0); PG8_MMA(0, 1, At, B1); PG8_BAR;
            PG8_LDA(At, 1, 1); PG8_STAGE(PG8_SA(1, 0), a3, voffA);
            PG8_BAR; PG8_WAIT_L(0); PG8_MMA(1, 0, At, B0); PG8_BAR; PG8_SCHED;
            PG8_STAGE(PG8_SB(1, 1), b3 + hstepB, voffB);
            PG8_WAIT_V(6); PG8_BAR; PG8_MMA(1, 1, At, B1); PG8_BAR;
            }
        }
        if constexpr (ALIGN_EPI) { if (wr == 0) PG8_BAR; }
        if constexpr (!Epi::AFTER_DRAIN) { E(acc, cur, wr, wc, fr, fq); S.done(cur); }
        if (!has_next) break;
#pragma unroll
        for (int a = 0; a < 2; ++a)
#pragma unroll
            for (int b = 0; b < 2; ++b)
#pragma unroll
                for (int m = 0; m < 4; ++m)
#pragma unroll
                    for (int n = 0; n < 2; ++n) acc[a][b][m][n] = (f32x4){0.f, 0.f, 0.f, 0.f};
        cur = nxt; cA = nA; cB = nB; ++ui;
        if constexpr (ALIGN_EPI) { if (wr == 1) PG8_BAR; }
    }
    PG8_WAIT_V(0);
    if constexpr (!ALIGN_EPI) { if (wr == 0) PG8_BAR; }
    PG8_BAR;
    if constexpr (Epi::AFTER_DRAIN) { E.fused(acc, cur, wr, wc, fr, fq, lds, wid, lane); S.done(cur); }
#undef PG8_SA
#undef PG8_SB
#undef PG8_STAGE
#undef PG8_LDA
#undef PG8_LDB
#undef PG8_MMA
#undef PG8_WAIT_V
#undef PG8_WAIT_L
#undef PG8_BAR
#undef PG8_SCHED
}
}

namespace att {
constexpr int SHM_V = 16384, SHM_K = 16384;
constexpr int OFF_V = 0, OFF_K = 32768, OFF_WS = 65536, OFF_LUT = 67584, OFF_G = 69632, OFF_XCH = 0;
constexpr float THR = 8.f;
#define KSWZ(row, colB) ((row) * 256 + ((colB) ^ (((row) & 7) << 4)))
#define SBAR() __builtin_amdgcn_sched_barrier(0)
__device__ __forceinline__ int crow(int r, int hi) { return (r & 3) + 8 * (r >> 2) + 4 * hi; }
__device__ __forceinline__ int v_st(int k, int c) { const int kk = (k & ~0xC) | ((k & 4) << 1) | ((k & 8) >> 1); return ((kk >> 3) * 4 + (c >> 5)) * 512 + ((kk & 7) * 32 + (c & 31)) * 2; }
__device__ __forceinline__ int v_rd_base(int lane) { return ((lane & 3) << 3) | (((lane >> 2) & 3) << 6) | (((lane >> 4) & 1) << 5) | (((lane >> 5) & 1) << 8); }
constexpr int v_rd_off(int d0, int ks, int half) { return d0 * 512 + ks * 4096 + half * 2048; }
template <int OFF> __device__ __forceinline__ s16x4 tr_read(int vb) { s16x4 r; asm volatile("ds_read_b64_tr_b16 %0, %1 offset:%2" : "=&v"(r) : "v"(vb), "i"(OFF) : "memory"); return r; }
template <int D0> __device__ __forceinline__ void pv_one(f32x16& od, int vb, bf16x8 pa0, bf16x8 pa1, bf16x8 pa2, bf16x8 pa3) {
  const s16x4 l0 = tr_read<v_rd_off(D0, 0, 0)>(vb), h0 = tr_read<v_rd_off(D0, 0, 1)>(vb), l1 = tr_read<v_rd_off(D0, 1, 0)>(vb), h1 = tr_read<v_rd_off(D0, 1, 1)>(vb);
  const s16x4 l2 = tr_read<v_rd_off(D0, 2, 0)>(vb), h2 = tr_read<v_rd_off(D0, 2, 1)>(vb), l3 = tr_read<v_rd_off(D0, 3, 0)>(vb), h3 = tr_read<v_rd_off(D0, 3, 1)>(vb);
  asm volatile("s_waitcnt lgkmcnt(0)" ::: "memory"); SBAR();
#define PK(L, H) (bf16x8){L[0], L[1], L[2], L[3], H[0], H[1], H[2], H[3]}
  od = __builtin_amdgcn_mfma_f32_32x32x16_bf16(pa0, PK(l0, h0), od, 0, 0, 0);
  od = __builtin_amdgcn_mfma_f32_32x32x16_bf16(pa1, PK(l1, h1), od, 0, 0, 0);
  od = __builtin_amdgcn_mfma_f32_32x32x16_bf16(pa2, PK(l2, h2), od, 0, 0, 0);
  od = __builtin_amdgcn_mfma_f32_32x32x16_bf16(pa3, PK(l3, h3), od, 0, 0, 0);
#undef PK
}

template <int KS> __device__ __forceinline__ void pv_ks(f32x16 (&o)[4], int vb, bf16x8 pa) {
  const s16x4 l0 = tr_read<v_rd_off(0, KS, 0)>(vb), h0 = tr_read<v_rd_off(0, KS, 1)>(vb), l1 = tr_read<v_rd_off(1, KS, 0)>(vb), h1 = tr_read<v_rd_off(1, KS, 1)>(vb);
  const s16x4 l2 = tr_read<v_rd_off(2, KS, 0)>(vb), h2 = tr_read<v_rd_off(2, KS, 1)>(vb), l3 = tr_read<v_rd_off(3, KS, 0)>(vb), h3 = tr_read<v_rd_off(3, KS, 1)>(vb);
  asm volatile("s_waitcnt lgkmcnt(0)" ::: "memory"); SBAR();
#define PK(L, H) (bf16x8){L[0], L[1], L[2], L[3], H[0], H[1], H[2], H[3]}
  o[0] = __builtin_amdgcn_mfma_f32_32x32x16_bf16(pa, PK(l0, h0), o[0], 0, 0, 0);
  o[1] = __builtin_amdgcn_mfma_f32_32x32x16_bf16(pa, PK(l1, h1), o[1], 0, 0, 0);
  o[2] = __builtin_amdgcn_mfma_f32_32x32x16_bf16(pa, PK(l2, h2), o[2], 0, 0, 0);
  o[3] = __builtin_amdgcn_mfma_f32_32x32x16_bf16(pa, PK(l3, h3), o[3], 0, 0, 0);
#undef PK
}

struct AttnP { const bf16_t* qkv; const float* logf; bf16_t* att; const float* rel_table; const float* subln; };

template <int MODE>
__device__ __forceinline__ void attn_unit(const AttnP& P, int b, int h, int u, int j0, char* lds, float lam) {
  constexpr int NQ = MODE == 0 ? 4 : 8;
  const int tid = threadIdx.x, wid = tid >> 6, lane = tid & 63, r32 = lane & 31, hi = lane >> 5;
  const long rowbase = (long)b * SEQ;
  const int qg = wid >> 1, map = wid & 1;
  const int qw = MODE == 0 ? 128 * u + 32 * qg : 256 * u + 32 * wid;
  const int NT = MODE == 0 ? 2 * u + 2 : 4 * u + 4;
  const int NTw = MODE == 0 ? 2 * u + 1 + (qg >> 1) : 4 * u + (wid >> 1) + 1;
  const int kcolB = MODE == 0 ? map * 128 : 0;
  const bf16_t* Qb = P.qkv + (size_t)(MODE == 0 ? 0 : 3) * MT * 1024;
  const bf16_t* Kh = P.qkv + (size_t)(MODE == 0 ? 1 : 4) * MT * 1024 + rowbase * 1024 + h * 128;
  const bf16_t* Vh = P.qkv + (size_t)(MODE == 0 ? 2 : 5) * MT * 1024 + rowbase * 1024 + h * 128;
  char* V_lds = lds + OFF_V; char* K_lds = lds + OFF_K;
  float* wsf = (float*)(lds + OFF_WS) + wid * 64; float* li_l = wsf; float* al_l = wsf + 32;
  const float* lut = (const float*)(lds + OFF_LUT); const float* Gl = (const float*)(lds + OFF_G);
  bf16x8 qr[NQ];
  { const bf16_t* Qw = Qb + (rowbase + qw + r32) * 1024 + h * 128 + (MODE == 0 ? map * 64 : 0) + hi * 8;
#pragma unroll
    for (int d0 = 0; d0 < NQ; ++d0) qr[d0] = *(const bf16x8*)(Qw + d0 * 16); }
  const int sr = tid >> 4, sc = (tid & 15) * 8, vst0 = v_st(sr, sc), vst1 = v_st(32 + sr, sc);
  const int vb0 = (int)(uintptr_t)V_lds + v_rd_base(lane);
  bf16x8 vs0, vs1, ks0, ks1;
#define SLOAD(k0) do { vs0 = *(const bf16x8*)(Vh + (long)((k0) + sr) * 1024 + sc); vs1 = *(const bf16x8*)(Vh + (long)((k0) + 32 + sr) * 1024 + sc); \
    ks0 = *(const bf16x8*)(Kh + (long)((k0) + sr) * 1024 + sc); ks1 = *(const bf16x8*)(Kh + (long)((k0) + 32 + sr) * 1024 + sc); } while (0)
#define SWRITE(bb) do { *(bf16x8*)(V_lds + (bb) * SHM_V + vst0) = vs0; *(bf16x8*)(V_lds + (bb) * SHM_V + vst1) = vs1; const int kc = sc * 2; \
    *(bf16x8*)(K_lds + (bb) * SHM_K + KSWZ(sr, kc)) = ks0; *(bf16x8*)(K_lds + (bb) * SHM_K + KSWZ(32 + sr, kc)) = ks1; } while (0)
  float mref = 0.f, l_reg = 0.f; f32x16 o[4], negm;
#pragma unroll
  for (int d = 0; d < 4; ++d) o[d] = f32x16{};
  float b15 = 0.f; if (MODE == 0) b15 = P.rel_table[15 * 8 + h] * LOG2E;
#pragma unroll
  for (int r = 0; r < 16; ++r) negm[r] = b15;
  SLOAD(j0 * 64); SWRITE(j0 & 1); if (j0 + 1 < NT) SLOAD((j0 + 1) * 64);
  __syncthreads();
  for (int j = j0; j < NT; ++j) {
    const int buf = j & 1;
    if (j < NTw) {
      f32x16 p0, p1;
      const bool far = (MODE == 0) && (j * 64 + 63 <= qw - 128);
      if (far) { p0 = negm; p1 = negm; }
      else if (MODE == 0) { const int idx0 = j * 64 - (qw + r32) + 255;
#pragma unroll
        for (int r = 0; r < 16; ++r) { p0[r] = lut[idx0 + crow(r, hi)] - mref; p1[r] = lut[idx0 + 32 + crow(r, hi)] - mref; }
      } else {
#pragma unroll
        for (int r = 0; r < 16; ++r) { p0[r] = Gl[j * 64 + crow(r, hi)] - mref; p1[r] = Gl[j * 64 + 32 + crow(r, hi)] - mref; }
      }
      const char* Ks = K_lds + buf * SHM_K;
#pragma unroll
      for (int d0 = 0; d0 < NQ; ++d0) { const int cb = kcolB + (d0 * 16 + hi * 8) * 2;
        const bf16x8 k0 = *(const bf16x8*)(Ks + KSWZ(r32, cb)); const bf16x8 k1 = *(const bf16x8*)(Ks + KSWZ(32 + r32, cb));
        p0 = __builtin_amdgcn_mfma_f32_32x32x16_bf16(k0, qr[d0], p0, 0, 0, 0);
        p1 = __builtin_amdgcn_mfma_f32_32x32x16_bf16(k1, qr[d0], p1, 0, 0, 0); }
      if (MODE == 1) {
        if (j * 64 + 63 > qw) { const int qq = qw + r32;
#pragma unroll
          for (int r = 0; r < 16; ++r) { const int key = j * 64 + crow(r, hi); if (key > qq) p0[r] = -1e30f; if (key + 32 > qq) p1[r] = -1e30f; }
        }
      }
#define PK4(Pv, BASE, OUT) do { unsigned a0 = cvt_pk_bf16(Pv[BASE + 0], Pv[BASE + 1]), a1 = cvt_pk_bf16(Pv[BASE + 2], Pv[BASE + 3]);   \
    unsigned b0 = cvt_pk_bf16(Pv[BASE + 4], Pv[BASE + 5]), b1 = cvt_pk_bf16(Pv[BASE + 6], Pv[BASE + 7]);                              \
    auto r0 = __builtin_amdgcn_permlane32_swap(a0, b0, false, false); auto r1 = __builtin_amdgcn_permlane32_swap(a1, b1, false, false); \
    u32x4 w = {r0[0], r1[0], r0[1], r1[1]}; OUT = *reinterpret_cast<bf16x8*>(&w); } while (0)
#define SM_HALF(PV, PO, ADJ, PAa, PAb) do { \
      float pm_ = PV[0]; \
      _Pragma("unroll") for (int r = 1; r < 16; ++r) pm_ = fmaxf(pm_, PV[r]); \
      { auto rr = __builtin_amdgcn_permlane32_swap(__float_as_uint(pm_), __float_as_uint(pm_), false, false); pm_ = fmaxf(__uint_as_float(rr[0]), __uint_as_float(rr[1])); } \
      if (__any(pm_ > THR)) { const float dl = fmaxf(pm_, 0.f); mref += dl; \
        _Pragma("unroll") for (int r = 0; r < 16; ++r) { PV[r] -= dl; if (ADJ) PO[r] -= dl; if (MODE == 0) negm[r] -= dl; } \
        const float f = __builtin_amdgcn_exp2f(-dl); l_reg *= f; \
        if (hi == 0) al_l[r32] = f; asm volatile("s_waitcnt lgkmcnt(0)" ::: "memory"); \
        _Pragma("unroll") for (int r = 0; r < 16; ++r) { const float fr_ = al_l[crow(r, hi)]; \
          _Pragma("unroll") for (int d = 0; d < 4; ++d) o[d][r] *= fr_; } } \
      _Pragma("unroll") for (int r = 0; r < 16; ++r) PV[r] = __builtin_amdgcn_exp2f(PV[r]); \
      { float ps = PV[0]; \
        _Pragma("unroll") for (int r = 1; r < 16; ++r) ps += PV[r]; \
        auto rr = __builtin_amdgcn_permlane32_swap(__float_as_uint(ps), __float_as_uint(ps), false, false); l_reg += __uint_as_float(rr[0]) + __uint_as_float(rr[1]); } \
      PK4(PV, 0, PAa); PK4(PV, 8, PAb); } while (0)
      const int vb = vb0 + buf * SHM_V;
      bf16x8 pa0, pa1, pa2, pa3;
      SM_HALF(p0, p1, 1, pa0, pa1);
      pv_ks<0>(o, vb, pa0); pv_ks<1>(o, vb, pa1);
      SM_HALF(p1, p0, 0, pa2, pa3);
      pv_ks<2>(o, vb, pa2); pv_ks<3>(o, vb, pa3);
#undef SM_HALF
#undef PK4
    }
    if (j + 1 < NT) { SWRITE(buf ^ 1); if (j + 2 < NT) SLOAD((j + 2) * 64); }
    __syncthreads();
  }
#undef SLOAD
#undef SWRITE
  if (hi == 0) li_l[r32] = l_reg; asm volatile("s_waitcnt lgkmcnt(0)" ::: "memory");
  float rli[16];
#pragma unroll
  for (int r = 0; r < 16; ++r) rli[r] = __builtin_amdgcn_rcpf(li_l[crow(r, hi)]);
  if (MODE == 1) {
    bf16_t* Ow = P.att + (size_t)(rowbase + qw) * 2048 + 1024 + h * 128 + r32;
#pragma unroll
    for (int r = 0; r < 16; ++r) { const int orow = crow(r, hi);
#pragma unroll
      for (int d0 = 0; d0 < 4; ++d0) Ow[(size_t)orow * 2048 + d0 * 32] = (bf16_t)(cvt_pk_bf16(o[d0][r] * rli[r], 0.f) & 0xffffu); }
  } else {
    float* xo = (float*)(lds + (map ? OFF_XCH : OFF_G)) + qg * (32 * 128);
#pragma unroll
    for (int r = 0; r < 16; ++r) { const int orow = crow(r, hi);
#pragma unroll
      for (int d0 = 0; d0 < 4; ++d0) xo[orow * 128 + d0 * 32 + r32] = o[d0][r] * rli[r]; }
    __syncthreads();
    { const int row = tid >> 2, q4 = tid & 3;
      const float* x1 = (const float*)(lds + OFF_G) + row * 128 + 32 * q4; const float* x2 = (const float*)(lds + OFF_XCH) + row * 128 + 32 * q4;
      f32x4 v[8]; float ss = 0.f;
#pragma unroll
      for (int i = 0; i < 8; ++i) { v[i] = *(const f32x4*)(x1 + 4 * i) - lam * *(const f32x4*)(x2 + 4 * i); ss += (v[i].x * v[i].x + v[i].y * v[i].y) + (v[i].z * v[i].z + v[i].w * v[i].w); }
      ss += __shfl_xor(ss, 1); ss += __shfl_xor(ss, 2);
      const float rs = rsqrtf(ss * (1.f / 128.f) + EPS) * (1.f - LAM_INIT);
      bf16_t* Ow = P.att + (size_t)(rowbase + 128 * u + row) * 2048 + h * 128 + 32 * q4;
#pragma unroll
      for (int i = 0; i < 4; ++i) { const f32x4 s0 = *(const f32x4*)(P.subln + 32 * q4 + 8 * i), s1 = *(const f32x4*)(P.subln + 32 * q4 + 8 * i + 4);
        *(u32x4*)(Ow + 8 * i) = pack8(v[2 * i] * s0 * rs, v[2 * i + 1] * s1 * rs); } }
    __syncthreads();
  }
}

__device__ __forceinline__ int fox_setup(const float* logf, const float* nrm, int b, int h, int q0, char* lds) {
  const int tid = threadIdx.x, wid = tid >> 6, lane = tid & 63;
  float* Gl = (float*)(lds + OFF_G); float* wt = (float*)(lds + OFF_WS);
  const float* src = logf + ((size_t)b * SEQ + (size_t)tid * 16) * 8 + h;
  float loc[16]; float s = 0.f;
#pragma unroll
  for (int i = 0; i < 16; ++i) { s += src[i * 8]; loc[i] = s; }
  float inc = s;
#pragma unroll
  for (int o = 1; o < 64; o <<= 1) { const float t = __shfl_up(inc, o); if (lane >= o) inc += t; }
  __syncthreads();
  if (lane == 63) wt[wid] = inc;
  __syncthreads();
  float off = inc - s;
  for (int w = 0; w < wid; ++w) off += wt[w];
#pragma unroll
  for (int i = 0; i < 16; ++i) Gl[tid * 16 + i] = (off + loc[i]) * LOG2E;
  __syncthreads();
  const float fref = Gl[q0];
  __syncthreads();
#pragma unroll
  for (int i = 0; i < 16; ++i) Gl[tid * 16 + i] = fref - Gl[tid * 16 + i];
  __syncthreads();
  const float* nq = nrm + (b * 8 + h) * 4; const float* nk = nrm + 64 + (b * 8 + h) * 4;
  const float smax = sqrtf((nq[0] + nq[1]) + (nq[2] + nq[3])) * sqrtf((nk[0] + nk[1]) + (nk[2] + nk[3])) * 1.02f;
  const float thr = -(2.f * smax + 64.f);
  int lo = 0, hi = q0 >> 6;
  while (lo < hi) { const int mid = (lo + hi) >> 1; if (Gl[mid * 64 + 63] > thr) hi = mid; else lo = mid + 1; }
  return __builtin_amdgcn_readfirstlane(lo);
}
__device__ __forceinline__ int fox_rebase(const float* nrm, int b, int h, int q0, char* lds) {
  const int tid = threadIdx.x; float* Gl = (float*)(lds + OFF_G);
  __syncthreads();
  const float c = Gl[q0];
  __syncthreads();
#pragma unroll
  for (int i = 0; i < 16; ++i) Gl[tid * 16 + i] -= c;
  __syncthreads();
  const float* nq = nrm + (b * 8 + h) * 4; const float* nk = nrm + 64 + (b * 8 + h) * 4;
  const float smax = sqrtf((nq[0] + nq[1]) + (nq[2] + nq[3])) * sqrtf((nk[0] + nk[1]) + (nk[2] + nk[3])) * 1.02f;
  const float thr = -(2.f * smax + 64.f);
  int lo = 0, hi = q0 >> 6;
  while (lo < hi) { const int mid = (lo + hi) >> 1; if (Gl[mid * 64 + 63] > thr) hi = mid; else lo = mid + 1; }
  return __builtin_amdgcn_readfirstlane(lo);
}
__device__ __forceinline__ void diff_setup(const float* rel_table, int h, char* lds) {
  float* lut = (float*)(lds + OFF_LUT);
  __syncthreads();
  for (int i = threadIdx.x; i < 320; i += 512) lut[i] = rel_table[t5_bucket(i - 255) * 8 + h] * LOG2E;
  __syncthreads();
}
#undef SBAR
}

namespace smp {
constexpr int SST = 1056;
constexpr int OFF_S1 = 0, OFF_S2 = 67584, OFF_F = 135168, OFF_RED = 67584;
struct SampP { const bf16_t* qkv; const float* logf; const float* ck[2]; const float* cv[2]; const float* clogf; bf16_t* att; const float* rel_table; const float* subln; };

__device__ __forceinline__ bf16x8 ld8f(const float* p) { const f32x4 a = *(const f32x4*)p, b = *(const f32x4*)(p + 4); const u32x4 w = pack8(a, b); return __builtin_bit_cast(bf16x8, w); }

template <int BR>
__device__ __forceinline__ void sample_unit(const SampP& P, int bs, int h, char* lds, float lam) {
  const int tid = threadIdx.x, wid = tid >> 6, lane = tid & 63, l15 = lane & 15, g = lane >> 4;
  float* S1 = (float*)(lds + OFF_S1); float* S2 = (float*)(lds + OFF_S2); float* Fl = (float*)(lds + OFF_F); float* red = (float*)(lds + OFF_RED);
  const size_t qrow = (size_t)MP + bs * 16;
  const bf16_t* Qb = P.qkv + (size_t)(BR == 0 ? 0 : 3) * MT * 1024 + (qrow + l15) * 1024 + h * 128 + 8 * g;
  const bf16_t* Kn = P.qkv + (size_t)(BR == 0 ? 1 : 4) * MT * 1024 + qrow * 1024 + h * 128;
  const bf16_t* Vn = P.qkv + (size_t)(BR == 0 ? 2 : 5) * MT * 1024 + qrow * 1024 + h * 128;
  const float* Kc = P.ck[BR] + ((size_t)bs * PAST * 8 + h) * 128;
  const float* Vc = P.cv[BR] + ((size_t)bs * PAST * 8 + h) * 128;
  bf16x8 qf[4];
#pragma unroll
  for (int s = 0; s < 4; ++s) qf[s] = *(const bf16x8*)(Qb + 32 * s);
  __syncthreads();
  if (BR == 1) {
    if (wid == 0) {
      float loc[17]; float s = 0.f;
#pragma unroll
      for (int i = 0; i < 17; ++i) { const int j = lane * 17 + i; float v = 0.f;
        if (j < PAST) v = P.clogf[((size_t)bs * PAST + j) * 8 + h]; else if (j < PAST + 16) v = P.logf[(qrow + (j - PAST)) * 8 + h];
        s += v; loc[i] = s; }
      float inc = s;
#pragma unroll
      for (int o = 1; o < 64; o <<= 1) { const float t = __shfl_up(inc, o); if (lane >= o) inc += t; }
      const float off = inc - s;
#pragma unroll
      for (int i = 0; i < 17; ++i) { const int j = lane * 17 + i; if (j < PAST + 16) Fl[j] = (off + loc[i]) * LOG2E; }
    }
    __syncthreads();
  }
#define LOADK(KF, kb_) do { if ((kb_) < 64) { const float* kp = Kc + (size_t)(16 * (kb_) + l15) * 1024 + 8 * g; \
      _Pragma("unroll") for (int s = 0; s < 4; ++s) KF[s] = ld8f(kp + 32 * s); } \
    else { const bf16_t* kp = Kn + (size_t)l15 * 1024 + 8 * g; _Pragma("unroll") for (int s = 0; s < 4; ++s) KF[s] = *(const bf16x8*)(kp + 32 * s); } } while (0)
#define SCOREK(KF, kb_) do { const int key0 = 16 * (kb_) + 4 * g; \
    if (BR == 1) { f32x4 a = {0.f, 0.f, 0.f, 0.f}; \
      _Pragma("unroll") for (int s = 0; s < 4; ++s) a = __builtin_amdgcn_mfma_f32_16x16x32_bf16(KF[s], qf[s], a, 0, 0, 0); \
      const float fq = Fl[PAST + l15]; \
      _Pragma("unroll") for (int i = 0; i < 4; ++i) { const int key = key0 + i; a[i] = key > PAST + l15 ? -1e30f : a[i] + (fq - Fl[key]); } \
      *(f32x4*)(S1 + l15 * SST + key0) = a; \
    } else { f32x4 a1 = {0.f, 0.f, 0.f, 0.f}, a2 = {0.f, 0.f, 0.f, 0.f}; \
      a1 = __builtin_amdgcn_mfma_f32_16x16x32_bf16(KF[0], qf[0], a1, 0, 0, 0); a1 = __builtin_amdgcn_mfma_f32_16x16x32_bf16(KF[1], qf[1], a1, 0, 0, 0); \
      a2 = __builtin_amdgcn_mfma_f32_16x16x32_bf16(KF[2], qf[2], a2, 0, 0, 0); a2 = __builtin_amdgcn_mfma_f32_16x16x32_bf16(KF[3], qf[3], a2, 0, 0, 0); \
      _Pragma("unroll") for (int i = 0; i < 4; ++i) { const float bias = P.rel_table[t5_bucket(key0 + i - (PAST + l15)) * 8 + h] * LOG2E; a1[i] += bias; a2[i] += bias; } \
      *(f32x4*)(S1 + l15 * SST + key0) = a1; *(f32x4*)(S2 + l15 * SST + key0) = a2; } } while (0)
  for (int kb = wid; kb < 65; kb += 16) {
    bf16x8 kfa[4], kfb[4]; const bool two = kb + 8 < 65;
    LOADK(kfa, kb); if (two) LOADK(kfb, kb + 8);
    SCOREK(kfa, kb); if (two) SCOREK(kfb, kb + 8);
  }
#undef LOADK
#undef SCOREK
  __syncthreads();
#pragma unroll
  for (int rr = 0; rr < 2; ++rr) { const int q = 2 * wid + rr;
#pragma unroll
    for (int mp = 0; mp < (BR == 0 ? 2 : 1); ++mp) { float* S = (mp == 0 ? S1 : S2) + q * SST;
      float mx = -1e30f; for (int j = lane; j < PAST + 16; j += 64) mx = fmaxf(mx, S[j]);
      mx = wave_max(mx);
      float sm = 0.f; for (int j = lane; j < PAST + 16; j += 64) { const float e = __builtin_amdgcn_exp2f(S[j] - mx); S[j] = e; sm += e; }
      sm = wave_sum(sm); const float inv = 1.f / sm;
      for (int j = lane; j < PAST + 16; j += 64) S[j] *= inv; }
    if (BR == 0) { float* A = S1 + q * SST; const float* Bm = S2 + q * SST; for (int j = lane; j < PAST + 16; j += 64) A[j] -= lam * Bm[j]; }
  }
  __syncthreads();
  { const int hf = lane >> 5, l31 = lane & 31;
    f32x4 acc[16];
#pragma unroll
    for (int q = 0; q < 16; ++q) acc[q] = (f32x4){0.f, 0.f, 0.f, 0.f};
#pragma unroll 1
    for (int k5 = 0; k5 < 13; ++k5) { const int keyb = 130 * wid + 10 * k5 + hf;
      f32x4 v[5];
#pragma unroll
      for (int e = 0; e < 5; ++e) { const int key = keyb + 2 * e;
        if (key < PAST) v[e] = *(const f32x4*)(Vc + (size_t)key * 1024 + 4 * l31);
        else { const u32x2 w = *(const u32x2*)(Vn + (size_t)(key - PAST) * 1024 + 4 * l31); v[e] = (f32x4){bflo(w.x), bfhi(w.x), bflo(w.y), bfhi(w.y)}; } }
#pragma unroll
      for (int e = 0; e < 5; ++e) { const float* sp = S1 + keyb + 2 * e;
#pragma unroll
        for (int q = 0; q < 16; ++q) acc[q] += sp[q * SST] * v[e];
        asm volatile("" ::: "memory"); }
    }
#pragma unroll
    for (int q = 0; q < 16; ++q) {
#pragma unroll
      for (int i = 0; i < 4; ++i) acc[q][i] += __shfl_xor(acc[q][i], 32); }
    __syncthreads();
    if (hf == 0) {
#pragma unroll
      for (int q = 0; q < 16; ++q) *(f32x4*)(red + (wid * 16 + q) * 128 + 4 * l31) = acc[q]; }
  }
  __syncthreads();
  { const int q = tid >> 5, d4 = (tid & 31) * 4; f32x4 o = {0.f, 0.f, 0.f, 0.f};
#pragma unroll
    for (int w = 0; w < 8; ++w) o += *(const f32x4*)(red + (w * 16 + q) * 128 + d4);
    if (BR == 0) { float ss = o[0] * o[0] + o[1] * o[1] + o[2] * o[2] + o[3] * o[3];
#pragma unroll
      for (int s = 1; s < 32; s <<= 1) ss += __shfl_xor(ss, s);
      const float rs = rsqrtf(ss * (1.f / 128.f) + EPS) * (1.f - LAM_INIT); const f32x4 sl = *(const f32x4*)(P.subln + d4); o = o * sl * rs; }
    u32x2 w; w.x = cvt_pk_bf16(o[0], o[1]); w.y = cvt_pk_bf16(o[2], o[3]);
    *(u32x2*)(P.att + (qrow + q) * 2048 + (BR == 0 ? 0 : 1024) + h * 128 + d4) = w; }
}
}

__device__ __forceinline__ int src_col(int mode, int n) {
  if (mode == 0) return n;
  if (mode == 1) return n < 6144 ? n : (n < 10240 ? n + 8 : (n < 10248 ? n - 10240 + 6144 : -1));
  const int pn = n >> 8, j = n & 255; return j < 128 ? pn * 128 + j : DFF + pn * 128 + (j - 128);
}
__device__ __forceinline__ void transpose_item(const float* W, int Nsrc, int mode, bf16_t* WT, int ldwt, int koff, int nblk, LAS float* scr, int item, int lane) {
  const int kb = item / nblk, nb = item % nblk, k0 = 64 * kb, n0 = 32 * nb;
  const int sc = src_col(mode, n0 + (lane & 31));
  float tv[32]; const float* wp = W + (size_t)(k0 + (lane >> 5)) * Nsrc + (sc >= 0 ? sc : 0);
#pragma unroll
  for (int i = 0; i < 32; ++i) tv[i] = __builtin_nontemporal_load(wp + (size_t)(2 * i) * Nsrc);
#pragma unroll
  for (int i = 0; i < 32; ++i) scr[(2 * i + (lane >> 5)) * 33 + (lane & 31)] = sc >= 0 ? tv[i] : 0.f;
  asm volatile("s_waitcnt lgkmcnt(0)" ::: "memory");
  const int c = lane & 7;
#pragma unroll
  for (int j = 0; j < 4; ++j) { const int n = (lane >> 3) + 8 * j; const LAS float* s = scr + (8 * c) * 33 + n;
    u32x4 o; o.x = cvt_pk_bf16(s[0 * 33], s[1 * 33]); o.y = cvt_pk_bf16(s[2 * 33], s[3 * 33]); o.z = cvt_pk_bf16(s[4 * 33], s[5 * 33]); o.w = cvt_pk_bf16(s[6 * 33], s[7 * 33]);
    *(u32x4*)(WT + (size_t)(n0 + n) * ldwt + koff + k0 + 8 * c) = o; }
  asm volatile("s_waitcnt lgkmcnt(0)" ::: "memory");
}

#define XB_TMO      128
#define XB_XCNT(j)  (256  + 64 * (j))
#define XB_XSUB(j)  (1280 + 64 * (j))
#define XB_XGEN(j)  (2304 + 64 * (j))
#define XB_TOP      3328
#define XB_TOPGEN   3392
#define XCD_BAR_WORDS 3456
#define XB_SPIN_CAP (1u << 18)

__device__ __forceinline__ unsigned xb_ld(unsigned* p)              { return __hip_atomic_load(p, __ATOMIC_RELAXED, __HIP_MEMORY_SCOPE_AGENT); }
__device__ __forceinline__ unsigned xb_add(unsigned* p, unsigned v) { return __hip_atomic_fetch_add(p, v, __ATOMIC_RELAXED, __HIP_MEMORY_SCOPE_AGENT); }
__device__ __forceinline__ unsigned xb_xcc_id() { return (unsigned)__builtin_amdgcn_s_getreg((3 << 11) | 20) & 0xFu; }
#define XB_SPIN(cond, bar) do { unsigned _sp = 0; while (cond) { __builtin_amdgcn_s_sleep(1); \
    if ((++_sp & 255u) == 0u) { if (xb_ld(&(bar)[XB_TMO])) break; if (_sp > XB_SPIN_CAP) { atomicAdd(&(bar)[XB_TMO], 1u); break; } } } } while (0)

struct XcdBarrier {
    unsigned* bar; unsigned x;
    volatile LAS unsigned* st;
};

__device__ __forceinline__ XcdBarrier xcd_barrier_post(unsigned* bar, volatile LAS unsigned* st) {
    XcdBarrier b; b.bar = bar; b.x = xb_xcc_id(); b.st = st;
    if (threadIdx.x == 0) (void)xb_add(&bar[XB_XCNT(b.x)], 1u);
    return b;
}
__device__ __forceinline__ void xcd_barrier_complete(unsigned* bar, unsigned x, unsigned& nloc, unsigned& nx) {
    const unsigned G = gridDim.x * gridDim.y * gridDim.z;
    unsigned sum, cnt, mine, sp = 0u;
    for (;;) {
        sum = 0u; cnt = 0u; mine = 0u;
#pragma unroll
        for (unsigned j = 0; j < 16; ++j) { const unsigned c = xb_ld(&bar[XB_XCNT(j)]); sum += c; cnt += (c > 0u) ? 1u : 0u; mine = (j == x) ? c : mine; }
        if (sum == G) break;
        __builtin_amdgcn_s_sleep(1);
        if ((++sp & 255u) == 0u) { if (xb_ld(&bar[XB_TMO])) break; if (sp > XB_SPIN_CAP) { atomicAdd(&bar[XB_TMO], 1u); break; } }
    }
    nloc = mine > 0u ? mine : 1u; nx = cnt > 0u ? cnt : 1u;
}

__device__ __forceinline__ void xcd_barrier(const XcdBarrier& b) {
    asm volatile("s_waitcnt vmcnt(0)" ::: "memory");
    __syncthreads();
    if (threadIdx.x == 0) {
        unsigned* bar = b.bar;
        __builtin_amdgcn_s_waitcnt(0);
        unsigned nloc = b.st[0], nx = b.st[1];
        if (nloc == 0u) { xcd_barrier_complete(bar, b.x, nloc, nx); b.st[0] = nloc; b.st[1] = nx; }
        const unsigned old = xb_add(&bar[XB_XSUB(b.x)], 1u);
        const unsigned gen = old / nloc;
        if (old + 1u == (gen + 1u) * nloc) {
            __builtin_amdgcn_fence(__ATOMIC_RELEASE, "agent");
            asm volatile("s_waitcnt vmcnt(0)" ::: "memory");
            const unsigned og = xb_add(&bar[XB_TOP], 1u);
            const unsigned tg = og / nx;
            if (og + 1u == (tg + 1u) * nx) xb_add(&bar[XB_TOPGEN], 1u);
            else XB_SPIN(xb_ld(&bar[XB_TOPGEN]) == tg, bar);
            __builtin_amdgcn_fence(__ATOMIC_ACQUIRE, "agent");
            xb_add(&bar[XB_XGEN(b.x)], 1u);
            asm volatile("s_waitcnt vmcnt(0)" ::: "memory");
        } else {
            XB_SPIN(xb_ld(&bar[XB_XGEN(b.x)]) == gen, bar);
            __builtin_amdgcn_fence(__ATOMIC_ACQUIRE, "agent");
            asm volatile("s_waitcnt vmcnt(0)" ::: "memory");
        }
    }
    __syncthreads();
}

__device__ __forceinline__ void transpose_item64(const float* W, int Nsrc, int mode, bf16_t* WT, int ldwt, int koff, int nblk, LAS float* scr, int item, int lane) {
  const int kb = item / nblk, nb = item % nblk, k0 = 64 * kb, n0 = 64 * nb;
  const int kr = lane >> 4, nq = (lane & 15) * 4;
  const int sc = src_col(mode, n0 + nq);
  const float* wp = W + (size_t)(k0 + kr) * Nsrc + (sc >= 0 ? sc : 0);
  f32x4 tv[16];
#pragma unroll
  for (int i = 0; i < 16; ++i) tv[i] = __builtin_nontemporal_load((const f32x4*)(wp + (size_t)(4 * i) * Nsrc));
#pragma unroll
  for (int i = 0; i < 16; ++i) { LAS float* d = scr + (4 * i + kr) * 65 + nq; const f32x4 v = sc >= 0 ? tv[i] : (f32x4){0.f, 0.f, 0.f, 0.f}; d[0] = v.x; d[1] = v.y; d[2] = v.z; d[3] = v.w; }
  asm volatile("s_waitcnt lgkmcnt(0)" ::: "memory");
  const int c = lane & 7, nl = lane >> 3;
#pragma unroll
  for (int j = 0; j < 8; ++j) { const int n = nl + 8 * j; const LAS float* s = scr + (8 * c) * 65 + n;
    u32x4 o; o.x = cvt_pk_bf16(s[0 * 65], s[1 * 65]); o.y = cvt_pk_bf16(s[2 * 65], s[3 * 65]); o.z = cvt_pk_bf16(s[4 * 65], s[5 * 65]); o.w = cvt_pk_bf16(s[6 * 65], s[7 * 65]);
    *(u32x4*)(WT + (size_t)(n0 + n) * ldwt + koff + k0 + 8 * c) = o; }
  asm volatile("s_waitcnt lgkmcnt(0)" ::: "memory");
}

struct Args { const float* in[27]; float* out; unsigned char* ws; int ph_lo, ph_hi; };

__global__ void __launch_bounds__(512, 2) mega_fwd(Args a) {
  extern __shared__ __attribute__((aligned(16))) unsigned char lds[];
  cg::grid_group grid = cg::this_grid();
  const int tid = threadIdx.x, lane = tid & 63, wave = __builtin_amdgcn_readfirstlane(tid >> 6);
  const int G = gridDim.x, bx = blockIdx.x;
  const int gw = bx * 8 + wave, NGW = G * 8;
  unsigned char* ws = a.ws; float* out = a.out;
  const float* x_p = a.in[0]; const float* x_s = a.in[1];
  bf16_t* WT_IN = (bf16_t*)(ws + WS_WT_IN); bf16_t* WT_MRG = (bf16_t*)(ws + WS_WT_MRG); bf16_t* WT_OUT = (bf16_t*)(ws + WS_WT_OUT);
  bf16_t* WT_UP = (bf16_t*)(ws + WS_WT_UP); bf16_t* WT_DN = (bf16_t*)(ws + WS_WT_DN); bf16_t* XN = (bf16_t*)(ws + WS_XN);
  bf16_t* QKV = (bf16_t*)(ws + WS_QKV); bf16_t* GATES = (bf16_t*)(ws + WS_GATES); float* LOGF = (float*)(ws + WS_LOGF);
  bf16_t* ATT = (bf16_t*)(ws + WS_ATT); bf16_t* T1 = (bf16_t*)(ws + WS_T1); bf16_t* GB = (bf16_t*)(ws + WS_G); bf16_t* MO = (bf16_t*)(ws + WS_MO);
  bf16_t* HH = (bf16_t*)(ws + WS_HH); float* TAIL = (float*)(ws + WS_TAIL); float* HEAD = (float*)(ws + WS_HEAD); float* PART = (float*)(ws + WS_ATT); float* NRM = (float*)(ws + WS_LOGF + 768 * 1024);
  PG8_LAS unsigned char* ldsl = (PG8_LAS unsigned char*)lds;
  const int lo = a.ph_lo, hi = a.ph_hi;
  volatile LAS unsigned* MISC = (volatile LAS unsigned*)((LAS unsigned char*)lds + MISC_OFF);
  if (tid < 32) MISC[tid] = 0u;
  __syncthreads();
  const XcdBarrier bar = xcd_barrier_post((unsigned*)(ws + WS_BAR), MISC + 8);
#ifndef PHMASK
#define PHMASK 0x3ff
#endif
#define IN(k) (((PHMASK >> (k)) & 1) && lo <= (k) && (k) < hi)
#ifndef DUPPH
#define DUPPH -1
#endif
#ifndef DUPATT
#define DUPATT 0
#endif
#define ATTREP(m) (((DUPATT) & (m)) ? 2 : 1)
#define REPS(k) ((DUPPH) == (k) ? 2 : 1)
#define SEAM(k) do { if (IN(k) && IN((k) + 1)) { if (lo < 0) grid.sync(); else xcd_barrier(bar); } } while (0)

  if (IN(0)) _Pragma("nounroll") for (int rep_ = 0; rep_ < REPS(0); ++rep_) {
    LAS float* scr = (LAS float*)(ldsl + wave * 16896);
    constexpr int I_IN = 32 * 164;
    for (int it = gw; it < I_IN; it += NGW) transpose_item64(a.in[10], NIN, 1, WT_IN, 2048, 0, 164, scr, it, lane);
    if (bx == 0 && tid < 128) NRM[tid] = 0.f;
    const float* gain = a.in[9];
    for (int m = gw; m < MT; m += NGW) {
      const float* xrow = m < MP ? x_p + (size_t)m * DM : x_s + (size_t)(m - MP) * DM;
      f32x4 v[8]; float ss = 0.f;
#pragma unroll
      for (int j = 0; j < 8; ++j) { v[j] = *(const f32x4*)(xrow + 4 * (64 * j + lane)); ss += (v[j].x * v[j].x + v[j].y * v[j].y) + (v[j].z * v[j].z + v[j].w * v[j].w); }
      const float r = rsqrtf(wave_sum(ss) * (1.f / DM) + EPS);
#pragma unroll
      for (int j = 0; j < 8; ++j) { const f32x4 gn = *(const f32x4*)(gain + 4 * (64 * j + lane)); const f32x4 y = v[j] * r * gn;
        u32x2 w; w.x = cvt_pk_bf16(y.x, y.y); w.y = cvt_pk_bf16(y.z, y.w); *(u32x2*)(XN + (size_t)m * DM + 4 * (64 * j + lane)) = w; }
    }
  }
  SEAM(0);
  if (IN(1)) _Pragma("nounroll") for (int rep_ = 0; rep_ < REPS(1); ++rep_) {
    pg8::Gemm g{XN, WT_IN, 2048, 2048, MT, NIN_PAD, 2048}; pg8::StaticOrder S; S.init(MT, NIN_PAD, G, bx, 2048);
    pg8::EpiIn E{QKV, GATES, LOGF, out, a.in[11], NRM, (PG8_LAS float*)(ldsl + STG_OFF)};
    pg8::gemm_phase<pg8::EpiIn, pg8::StaticOrder, true, true>(ldsl, g, S, E);
  }
  SEAM(1);
  if (IN(2)) {
    float lam;
    { const float d1 = wave_sum(a.in[12][lane] * a.in[13][lane]), d2 = wave_sum(a.in[14][lane] * a.in[15][lane]); lam = expf(d1) - expf(d2) + LAM_INIT; }
    const att::AttnP P{QKV, LOGF, ATT, a.in[8], a.in[16]};
    const int vcu = (G % 8 == 0) ? (bx & 7) * (G >> 3) + (bx >> 3) : bx;
#define CONVERT_REST() do { LAS float* scr = (LAS float*)(ldsl + wave * 16896); __syncthreads(); \
      constexpr int I_BD = 16 * 32, I_OUT = 32 * 32, I_UP = 32 * 256, I_DN = 128 * 32, NIT = 2 * I_BD + I_OUT + I_UP + I_DN; \
      for (int it = gw; it < NIT; it += NGW) { int r = it; \
        if (r < I_BD) { transpose_item64(a.in[17], 2048, 0, WT_MRG, 2048, 0, 32, scr, r, lane); continue; } r -= I_BD; \
        if (r < I_BD) { transpose_item64(a.in[18], 2048, 0, WT_MRG, 2048, 1024, 32, scr, r, lane); continue; } r -= I_BD; \
        if (r < I_OUT) { transpose_item64(a.in[19], 2048, 0, WT_OUT, 2048, 0, 32, scr, r, lane); continue; } r -= I_OUT; \
        if (r < I_UP) { transpose_item64(a.in[22], 16384, 2, WT_UP, 2048, 0, 256, scr, r, lane); continue; } r -= I_UP; \
        transpose_item64(a.in[25], 2048, 0, WT_DN, 8192, 0, 32, scr, r, lane); } \
      __syncthreads(); } while (0)
    if ((bx & 1) == 0) CONVERT_REST();
#ifndef ATTSUB
#define ATTSUB 7
#endif
    if (ATTSUB & 1) for (int pi_ = vcu; pi_ < 512 * ATTREP(1); pi_ += G) { const int pi = pi_ & 511; const int bh = pi >> 5, s = pi & 31, b = bh >> 3, h = bh & 7;
      att::diff_setup(a.in[8], h, (char*)lds);
      att::attn_unit<0>(P, b, h, s, 0, (char*)lds, lam);
      att::attn_unit<0>(P, b, h, 63 - s, 0, (char*)lds, lam); }
    if (ATTSUB & 2) for (int pi_ = vcu; pi_ < 256 * ATTREP(2); pi_ += G) { const int pi = pi_ & 255; const int bh = pi >> 4, s = pi & 15, b = bh >> 3, h = bh & 7;
      { const int j0 = att::fox_setup(LOGF, NRM, b, h, 256 * s, (char*)lds); att::attn_unit<1>(P, b, h, s, j0, (char*)lds, lam); }
      { const int j0 = att::fox_rebase(NRM, b, h, 256 * (31 - s), (char*)lds); att::attn_unit<1>(P, b, h, 31 - s, j0, (char*)lds, lam); } }
    const smp::SampP SP{QKV, LOGF, {a.in[2], a.in[4]}, {a.in[3], a.in[5]}, a.in[6], ATT, a.in[8], a.in[16]};
    if (ATTSUB & 4) for (int ui_ = bx; ui_ < 512 * ATTREP(4); ui_ += G) { const int ui = ui_ & 511; const int br = ui >> 8, bsh = ui & 255, bs = bsh >> 3, h = bsh & 7;
      if (br == 0) smp::sample_unit<0>(SP, bs, h, (char*)lds, lam); else smp::sample_unit<1>(SP, bs, h, (char*)lds, lam); }
    __syncthreads();
    if (bx & 1) CONVERT_REST();
#undef CONVERT_REST
  }
  SEAM(2);
  if (IN(3)) _Pragma("nounroll") for (int rep_ = 0; rep_ < REPS(3); ++rep_) {
    pg8::StaticOrder S; S.init(MT, 2048, G, bx, 1024);
    { pg8::Gemm g{ATT, WT_MRG, 2048, 2048, MT, 2048, 1024}; pg8::EpiMerge<0> E{GATES, T1, GB};
      pg8::gemm_phase<pg8::EpiMerge<0>, pg8::StaticOrder, true, true>(ldsl, g, S, E); }
    { pg8::Gemm g{ATT + 1024, WT_MRG + 1024, 2048, 2048, MT, 2048, 1024}; pg8::EpiMerge<1> E{GATES, T1, GB};
      pg8::gemm_phase<pg8::EpiMerge<1>, pg8::StaticOrder, true, true>(ldsl, g, S, E); }
  }
  SEAM(3);
  if (IN(4)) _Pragma("nounroll") for (int rep_ = 0; rep_ < REPS(4); ++rep_) {
    pg8::Gemm g{GB, WT_OUT, 2048, 2048, MT, 2048, 2048}; pg8::SplitOrder S; S.init(G, bx, 2048);
    pg8::EpiPlain E{MO, 2048, PART};
    pg8::gemm_phase<pg8::EpiPlain, pg8::SplitOrder, true, true>(ldsl, g, S, E);
  }
  SEAM(4);
  if (IN(5)) _Pragma("nounroll") for (int rep_ = 0; rep_ < REPS(5); ++rep_) {
    const float* g1 = a.in[20]; const float* g2 = a.in[21];
    for (int m = gw; m < MT; m += NGW) {
      const float* xrow = m < MP ? x_p + (size_t)m * DM : x_s + (size_t)(m - MP) * DM;
      f32x4 xin[8];
#pragma unroll
      for (int j = 0; j < 8; ++j) xin[j] = *(const f32x4*)(xrow + 4 * (64 * j + lane));
      f32x4 v[8]; float ss = 0.f;
#pragma unroll
      for (int j = 0; j < 8; ++j) {
        if (m < MP) { const u32x2 w = *(const u32x2*)(MO + (size_t)m * DM + 4 * (64 * j + lane)); v[j] = (f32x4){bflo(w.x), bfhi(w.x), bflo(w.y), bfhi(w.y)}; }
        else { v[j] = (f32x4){0.f, 0.f, 0.f, 0.f};
#pragma unroll
          for (int ks = 0; ks < 16; ++ks) v[j] += *(const f32x4*)(PART + ((size_t)ks * MSAMP + (m - MP)) * DM + 4 * (64 * j + lane)); }
        ss += (v[j].x * v[j].x + v[j].y * v[j].y) + (v[j].z * v[j].z + v[j].w * v[j].w); }
      const float r = rsqrtf(wave_sum(ss) * (1.f / DM) + EPS); float ss2 = 0.f;
#pragma unroll
      for (int j = 0; j < 8; ++j) { const f32x4 gn = *(const f32x4*)(g1 + 4 * (64 * j + lane)); const f32x4 xv = xin[j];
        v[j] = xv + v[j] * r * gn; *(f32x4*)(out + O_Y + (size_t)m * DM + 4 * (64 * j + lane)) = v[j];
        ss2 += (v[j].x * v[j].x + v[j].y * v[j].y) + (v[j].z * v[j].z + v[j].w * v[j].w); }
      const float r2 = rsqrtf(wave_sum(ss2) * (1.f / DM) + EPS);
#pragma unroll
      for (int j = 0; j < 8; ++j) { const f32x4 gn = *(const f32x4*)(g2 + 4 * (64 * j + lane)); const f32x4 y = v[j] * r2 * gn;
        u32x2 w; w.x = cvt_pk_bf16(y.x, y.y); w.y = cvt_pk_bf16(y.z, y.w); *(u32x2*)(XN + (size_t)m * DM + 4 * (64 * j + lane)) = w; }
    }
  }
  SEAM(5);
  if (IN(6)) _Pragma("nounroll") for (int rep_ = 0; rep_ < REPS(6); ++rep_) {
    pg8::Gemm g{XN, WT_UP, 2048, 2048, MT, 16384, 2048}; pg8::StaticOrder S; S.init(MT, 16384, G, bx, 2048);
    pg8::EpiUp E{HH, TAIL, HEAD, a.in[23], a.in[24], a.in[7], out, (PG8_LAS float*)(ldsl + XBUF_OFF)};
    pg8::gemm_phase<pg8::EpiUp, pg8::StaticOrder, true, true>(ldsl, g, S, E);
  }
  SEAM(6);
  if (IN(7)) {
    const float* cw = a.in[23]; const float* cb = a.in[24];
    for (int i = bx * 512 + tid; i < 64 * DFF; i += G * 512) { const int pm = i >> 13, c = i & (DFF - 1);
      const float* hp = HEAD + (size_t)pm * 4 * DFF + c; const float a0 = hp[0], b0 = hp[DFF], a1 = hp[2 * DFF], b1 = hp[3 * DFF];
      float t0 = 0.f, t1 = 0.f; if (pm & 31) { t0 = TAIL[((size_t)(pm - 1) * 2) * DFF + c]; t1 = TAIL[((size_t)(pm - 1) * 2 + 1) * DFF + c]; }
      const float w0 = cw[c], w1 = cw[DFF + c], w2 = cw[2 * DFF + c], bb = cb[c];
      const float ac0 = w0 * t0 + w1 * t1 + w2 * a0 + bb, ac1 = w0 * t1 + w1 * a0 + w2 * a1 + bb;
      HH[(size_t)(pm * 256) * DFF + c] = (bf16_t)(cvt_pk_bf16(gelu_tanh(ac0) * b0, 0.f) & 0xffffu);
      HH[(size_t)(pm * 256 + 1) * DFF + c] = (bf16_t)(cvt_pk_bf16(gelu_tanh(ac1) * b1, 0.f) & 0xffffu); }
  }
  SEAM(7);
  if (IN(8)) _Pragma("nounroll") for (int rep_ = 0; rep_ < REPS(8); ++rep_) {
    pg8::Gemm g{HH, WT_DN, 8192, 8192, MT, 2048, 8192}; pg8::SplitOrder S; S.init(G, bx, 8192);
    pg8::EpiPlain E{MO, 2048, PART};
    pg8::gemm_phase<pg8::EpiPlain, pg8::SplitOrder, true, true>(ldsl, g, S, E);
  }
  SEAM(8);
  if (IN(9)) {
    const float* g2 = a.in[26];
    for (int m = gw; m < MT; m += NGW) {
      f32x4 hin[8];
#pragma unroll
      for (int j = 0; j < 8; ++j) hin[j] = *(const f32x4*)(out + O_Y + (size_t)m * DM + 4 * (64 * j + lane));
      f32x4 v[8]; float ss = 0.f;
#pragma unroll
      for (int j = 0; j < 8; ++j) {
        if (m < MP) { const u32x2 w = *(const u32x2*)(MO + (size_t)m * DM + 4 * (64 * j + lane)); v[j] = (f32x4){bflo(w.x), bfhi(w.x), bflo(w.y), bfhi(w.y)}; }
        else { v[j] = (f32x4){0.f, 0.f, 0.f, 0.f};
#pragma unroll
          for (int ks = 0; ks < 16; ++ks) v[j] += *(const f32x4*)(PART + ((size_t)ks * MSAMP + (m - MP)) * DM + 4 * (64 * j + lane)); }
        ss += (v[j].x * v[j].x + v[j].y * v[j].y) + (v[j].z * v[j].z + v[j].w * v[j].w); }
      const float r = rsqrtf(wave_sum(ss) * (1.f / DM) + EPS);
#pragma unroll
      for (int j = 0; j < 8; ++j) { const f32x4 gn = *(const f32x4*)(g2 + 4 * (64 * j + lane)); float* yp = out + O_Y + (size_t)m * DM + 4 * (64 * j + lane);
        *(f32x4*)yp = hin[j] + v[j] * r * gn; }
    }
  }
#undef IN
#undef SEAM
}

extern "C" void kernel_launch(void* const* d_in, const int* in_sizes, int n_in, void* d_out, int out_size, void* d_ws, size_t ws_size, hipStream_t stream) {
  static int grid = 0;
  if (grid == 0) {
    if (n_in != 27 || in_sizes[0] != MP * DM || (size_t)out_size != O_END || ws_size < WS_END) {
      fprintf(stderr, "kernel_launch: unexpected shapes: n_in %d in0 %d out %d ws %zu (need %zu)\n", n_in, n_in > 0 ? in_sizes[0] : -1, out_size, ws_size, (size_t)WS_END); grid = -1; return; }
    int dev = 0, cus = 0, per_cu = 0;
    hipGetDevice(&dev); hipDeviceGetAttribute(&cus, hipDeviceAttributeMultiprocessorCount, dev);
    if (hipFuncSetAttribute((const void*)mega_fwd, hipFuncAttributeMaxDynamicSharedMemorySize, LDS_BYTES) != hipSuccess) { fprintf(stderr, "kernel_launch: hipFuncSetAttribute failed\n"); grid = -1; return; }
    if (hipOccupancyMaxActiveBlocksPerMultiprocessor(&per_cu, (const void*)mega_fwd, 512, LDS_BYTES) != hipSuccess || per_cu < 1) { fprintf(stderr, "kernel_launch: occupancy query gave %d\n", per_cu); per_cu = 1; }
    (void)hipGetLastError();
    grid = cus * 1;
    fprintf(stderr, "kernel_launch: cus %d per_cu %d grid %d ws %zu\n", cus, per_cu, grid, ws_size);
  }
  if (grid < 0) return;
  if (hipMemsetAsync((char*)d_ws + WS_BAR, 0, BAR_BYTES, stream) != hipSuccess) { fprintf(stderr, "kernel_launch: memset of the barrier words failed\n"); return; }
  Args a{};
  for (int i = 0; i < 27; ++i) a.in[i] = (const float*)d_in[i];
  a.out = (float*)d_out; a.ws = (unsigned char*)d_ws; a.ph_lo = 0; a.ph_hi = 10;
  void* args[] = {&a};
  hipError_t e = hipLaunchCooperativeKernel((const void*)mega_fwd, dim3(grid), dim3(512), args, LDS_BYTES, stream);
  if (e != hipSuccess) fprintf(stderr, "kernel_launch: cooperative launch failed: %s (grid %d)\n", hipGetErrorString(e), grid);
}
```
